# Optimizing an MI355X kernel written in HIP

```python
import jax, jax.numpy as jnp
from jax import lax
import numpy as np

D_MODEL = 1024
BATCH = 32
SEQ = 2048
DEPTH = 2

GRID_W = 64
CTX_LEN = 256
N_MIXERS = 2
N_MOD = 9
D_FF = 2816
FFN_RES_WEIGHT = 0.5
NORM_EPS = 1e-6
NEG_INF = -1e30
D_RNN = D_MODEL
RG_BLOCKS = 4
RG_BLOCK_W = D_RNN // RG_BLOCKS
CONV_W = 4
CONV_LEFT = 2
LRU_C = 8.0
HEAD_DIM = 64
N_HEADS = D_MODEL // HEAD_DIM
N_KV_HEADS = 4
GROUP = N_HEADS // N_KV_HEADS
WINDOW = 128
Q_BLOCK = 128
ROPE_BASE = 10000.0
ROPE_AXIS_DIM = HEAD_DIM // 2
N_A = (DEPTH + 1) // 2
N_B = DEPTH // 2

kernel_name = 'hybrid_rglru_swa_diffusion'


def rms_norm(x, g):
    xf = x.astype(jnp.float32)
    y = xf * lax.rsqrt(jnp.mean(xf * xf, axis=-1, keepdims=True) + NORM_EPS)
    return (y * g.astype(jnp.float32)).astype(x.dtype)


def modulate(h, g_pre, shift, scale):
    return rms_norm(h, g_pre) * (1 + scale) + shift


def modulation(cond, w, b):
    m = jax.nn.silu(cond) @ w + b
    return jnp.moveaxis(m.reshape(cond.shape[0], N_MOD, D_MODEL), 1, 0)[:, :, None, :]


def swiglu(h, w_in, w_out):
    gate, up = jnp.split(h @ w_in, 2, axis=-1)
    return (jax.nn.silu(gate) * up) @ w_out


def half_ffn_update(h, mod, k, g_pre, g_post, w_in, w_out):
    y = swiglu(modulate(h, g_pre, mod[3 * k], mod[3 * k + 1]), w_in, w_out)
    return h + FFN_RES_WEIGHT * mod[3 * k + 2] * rms_norm(y, g_post)


def centred_dwconv(x, w, b):
    L = x.shape[1]
    xp = jnp.pad(x, ((0, 0), (CONV_LEFT, CONV_W - 1 - CONV_LEFT), (0, 0)))
    out = b
    for k in range(CONV_W):
        out = out + xp[:, k:k + L] * w[k]
    return out


def _scan_combine(e1, e2):
    a1, b1 = e1
    a2, b2 = e2
    return a1 * a2, a2 * b1 + b2


def linear_scan(a, b, h0):
    a_cum, b_cum = lax.associative_scan(_scan_combine, (a, b), axis=1)
    return a_cum * h0[:, None] + b_cum


def rglru_coeffs(xr, gate_w, gate_b, lam):
    B_, L = xr.shape[:2]
    xb = xr.reshape(B_, L, RG_BLOCKS, RG_BLOCK_W)
    g = jnp.einsum('blnj,gnjk->gblnk', xb, gate_w).reshape(2, B_, L, D_RNN) + gate_b[:, None, None]
    g = jax.nn.sigmoid(g.astype(jnp.float32))
    r, i = g[0], g[1]
    log_a = -LRU_C * r * jax.nn.softplus(-lam.astype(jnp.float32))
    a = jnp.exp(log_a)
    b = jnp.sqrt(1.0 - jnp.exp(2.0 * log_a)) * (i * xr.astype(jnp.float32))
    return a, b


def rglru_mixer(hx, hc, w_in, conv_w, conv_b, gate_w, gate_b, lam, w_out, ctx_out):
    def branches(h):
        gate, xr = jnp.split(h @ w_in, 2, axis=-1)
        return jax.nn.gelu(gate), centred_dwconv(xr, conv_w, conv_b)
    gx, rx = branches(hx)
    gc, rc = branches(hc)
    h0 = jnp.zeros((hx.shape[0], D_RNN), jnp.float32)
    a, b = rglru_coeffs(rc, gate_w[0], gate_b[0], lam[0])
    sc_f = linear_scan(a, b, h0)
    a, b = rglru_coeffs(rx, gate_w[0], gate_b[0], lam[0])
    sx_f = linear_scan(a, b, sc_f[:, -1])
    a, b = rglru_coeffs(rc[:, ::-1], gate_w[1], gate_b[1], lam[1])
    sc_b = linear_scan(a, b, h0)
    a, b = rglru_coeffs(rx[:, ::-1], gate_w[1], gate_b[1], lam[1])
    sx_b = linear_scan(a, b, sc_b[:, -1])[:, ::-1]
    yx = (gx * (sx_f + sx_b).astype(hx.dtype)) @ w_out
    yc = (gc * (sc_f + sc_b[:, ::-1]).astype(hc.dtype)) @ w_out if ctx_out else None
    return yx, yc


def axial_rope_angles(L):
    rows = L // GRID_W
    row = jnp.repeat(jnp.arange(rows, dtype=jnp.float32), GRID_W)
    col = jnp.tile(jnp.arange(GRID_W, dtype=jnp.float32), rows)
    inv = 1.0 / (ROPE_BASE ** (jnp.arange(0, ROPE_AXIS_DIM, 2, dtype=jnp.float32) / ROPE_AXIS_DIM))
    return row[:, None] * inv, col[:, None] * inv


def rope_half(x, ang):
    x1, x2 = jnp.split(x, 2, axis=-1)
    cos = jnp.cos(ang)[:, None]
    sin = jnp.sin(ang)[:, None]
    return jnp.concatenate([x1 * cos - x2 * sin, x2 * cos + x1 * sin], axis=-1)


def apply_axial_rope(x, ang_row, ang_col):
    xf = x.astype(jnp.float32)
    x_row, x_col = jnp.split(xf, 2, axis=-1)
    return jnp.concatenate([rope_half(x_row, ang_row), rope_half(x_col, ang_col)], axis=-1).astype(x.dtype)


def softmax_with_sink(scores, sink):
    sink_col = jnp.broadcast_to(sink[None, :, :, None, None], scores.shape[:-1] + (1,))
    p = jax.nn.softmax(jnp.concatenate([scores, sink_col], axis=-1), axis=-1)
    return p[..., :-1]


def window_attention_mixer(hx, hc, w_qkv, w_o, sink, ctx_out):
    B_, L, _ = hx.shape
    C = hc.shape[1]

    def project(h):
        q, k, v = jnp.split(h @ w_qkv, [N_HEADS * HEAD_DIM, (N_HEADS + N_KV_HEADS) * HEAD_DIM], axis=-1)
        n = h.shape[1]
        return (q.reshape(B_, n, N_HEADS, HEAD_DIM), k.reshape(B_, n, N_KV_HEADS, HEAD_DIM),
                v.reshape(B_, n, N_KV_HEADS, HEAD_DIM))

    qx, kx, vx = project(hx)
    qc, kc, vc = project(hc)
    ang_row, ang_col = axial_rope_angles(L)
    qx = apply_axial_rope(qx, ang_row, ang_col).reshape(B_, L, N_KV_HEADS, GROUP, HEAD_DIM)
    kx = apply_axial_rope(kx, ang_row, ang_col)
    qc = qc.reshape(B_, C, N_KV_HEADS, GROUP, HEAD_DIM)
    scale = HEAD_DIM ** -0.5
    sink_kg = sink.reshape(N_KV_HEADS, GROUP).astype(jnp.float32)

    span = Q_BLOCK + 2 * WINDOW
    kp = jnp.pad(kx, ((0, 0), (WINDOW, WINDOW), (0, 0), (0, 0)))
    vp = jnp.pad(vx, ((0, 0), (WINDOW, WINDOW), (0, 0), (0, 0)))
    rel = jnp.arange(span)[None, :] - WINDOW - jnp.arange(Q_BLOCK)[:, None]
    band = jnp.abs(rel) <= WINDOW

    def block(n):
        start = n * Q_BLOCK
        qb = lax.dynamic_slice_in_dim(qx, start, Q_BLOCK, axis=1)
        kb = lax.dynamic_slice_in_dim(kp, start, span, axis=1)
        vb = lax.dynamic_slice_in_dim(vp, start, span, axis=1)
        key_pos = start - WINDOW + jnp.arange(span)
        valid = band & ((key_pos >= 0) & (key_pos < L))[None, :]
        s_lat = jnp.einsum('bqkgd,bskd->bkgqs', qb, kb).astype(jnp.float32) * scale
        s_lat = jnp.where(valid, s_lat, NEG_INF)
        s_ctx = jnp.einsum('bqkgd,bckd->bkgqc', qb, kc).astype(jnp.float32) * scale
        p = softmax_with_sink(jnp.concatenate([s_lat, s_ctx], axis=-1), sink_kg).astype(vx.dtype)
        return (jnp.einsum('bkgqs,bskd->bqkgd', p[..., :span], vb)
                + jnp.einsum('bkgqc,bckd->bqkgd', p[..., span:], vc))

    out = lax.map(block, jnp.arange(L // Q_BLOCK))
    yx = jnp.moveaxis(out, 0, 1).reshape(B_, L, N_HEADS * HEAD_DIM) @ w_o
    if not ctx_out:
        return yx, None
    s_c = jnp.einsum('bqkgd,bckd->bkgqc', qc, kc).astype(jnp.float32) * scale
    p_c = softmax_with_sink(s_c, sink_kg).astype(vc.dtype)
    yc = jnp.einsum('bkgqc,bckd->bqkgd', p_c, vc).reshape(B_, C, N_HEADS * HEAD_DIM) @ w_o
    return yx, yc


def setup_inputs(seed: int = 0) -> dict:
    key = jax.random.key(seed)
    ks = jax.random.split(key, 19)

    def normal(k, shape):
        return jax.random.normal(k, shape, jnp.float32)

    def dense(k, shape, fan_in):
        return normal(k, shape) * fan_in ** -0.5

    a0 = jax.random.uniform(ks[14], (N_A, 2, D_RNN), jnp.float32, minval=0.9, maxval=0.999)
    return {
        'x': normal(ks[0], (BATCH, SEQ, D_MODEL)),
        'c': normal(ks[1], (BATCH, D_MODEL)),
        'ctx': normal(ks[2], (BATCH, CTX_LEN, D_MODEL)),
        'c_ctx': normal(ks[3], (D_MODEL,)),
        'w_mod': 0.5 * dense(ks[4], (DEPTH, D_MODEL, N_MOD * D_MODEL), D_MODEL),
        'b_mod': 0.01 * normal(ks[5], (DEPTH, N_MOD * D_MODEL)),
        'norm_g': 1.0 + 0.02 * normal(ks[6], (DEPTH, 6, D_MODEL)),
        'ffn_w_in': dense(ks[7], (DEPTH, 2, D_MODEL, 2 * D_FF), D_MODEL),
        'ffn_w_out': dense(ks[8], (DEPTH, 2, D_FF, D_MODEL), D_FF),
        'rg_w_in': dense(ks[9], (N_A, D_MODEL, 2 * D_RNN), D_MODEL),
        'rg_conv_w': dense(ks[10], (N_A, CONV_W, D_RNN), CONV_W),
        'rg_conv_b': 0.01 * normal(ks[11], (N_A, D_RNN)),
        'rg_gate_w': dense(ks[12], (N_A, 2, 2, RG_BLOCKS, RG_BLOCK_W, RG_BLOCK_W), RG_BLOCK_W),
        'rg_gate_b': 0.01 * normal(ks[13], (N_A, 2, 2, D_RNN)),
        'rg_lambda': jnp.log(a0) - jnp.log1p(-a0),
        'rg_w_out': dense(ks[15], (N_A, D_RNN, D_MODEL), D_RNN),
        'attn_w_qkv': dense(ks[16], (N_B, D_MODEL, (N_HEADS + 2 * N_KV_HEADS) * HEAD_DIM), D_MODEL),
        'attn_w_o': dense(ks[17], (N_B, N_HEADS * HEAD_DIM, D_MODEL), N_HEADS * HEAD_DIM),
        'attn_sink': normal(ks[18], (N_B, N_HEADS)),
    }


def reference(x, c, ctx, c_ctx, w_mod, b_mod, norm_g, ffn_w_in, ffn_w_out,
              rg_w_in, rg_conv_w, rg_conv_b, rg_gate_w, rg_gate_b, rg_lambda, rg_w_out,
              attn_w_qkv, attn_w_o, attn_sink):
    xc = ctx
    for i in range(DEPTH):
        last = i == DEPTH - 1
        mx = modulation(c, w_mod[i], b_mod[i])
        mc = modulation(c_ctx[None], w_mod[i], b_mod[i])
        g = norm_g[i]
        x = half_ffn_update(x, mx, 0, g[0], g[3], ffn_w_in[i, 0], ffn_w_out[i, 0])
        xc = half_ffn_update(xc, mc, 0, g[0], g[3], ffn_w_in[i, 0], ffn_w_out[i, 0])
        hx = modulate(x, g[1], mx[3], mx[4])
        hc = modulate(xc, g[1], mc[3], mc[4])
        j = i // N_MIXERS
        if i % N_MIXERS == 0:
            yx, yc = rglru_mixer(hx, hc, rg_w_in[j], rg_conv_w[j], rg_conv_b[j], rg_gate_w[j],
                                 rg_gate_b[j], rg_lambda[j], rg_w_out[j], not last)
        else:
            yx, yc = window_attention_mixer(hx, hc, attn_w_qkv[j], attn_w_o[j], attn_sink[j], not last)
        x = x + mx[5] * rms_norm(yx, g[4])
        x = half_ffn_update(x, mx, 2, g[2], g[5], ffn_w_in[i, 1], ffn_w_out[i, 1])
        if not last:
            xc = xc + mc[5] * rms_norm(yc, g[4])
            xc = half_ffn_update(xc, mc, 2, g[2], g[5], ffn_w_in[i, 1], ffn_w_out[i, 1])
    return x
```

```cpp
#include <hip/hip_runtime.h>
#include <hip/hip_cooperative_groups.h>
#include <cstdio>
#include <cstdint>
namespace cg = cooperative_groups;

#ifndef MK_MULTI
#define MK_MULTI 0
#endif

typedef unsigned short bf16_t;
typedef short bf16x8 __attribute__((ext_vector_type(8)));
typedef float f32x4 __attribute__((ext_vector_type(4)));
typedef float f32x2 __attribute__((ext_vector_type(2)));
typedef unsigned u32x2 __attribute__((ext_vector_type(2)));
typedef unsigned u32x4 __attribute__((ext_vector_type(4)));
#define LAS __attribute__((address_space(3)))

constexpr int DM = 1024, NB = 32, SEQ = 2048, CTX = 256, DFF = 2816, NMOD = 9;
constexpr int XROWS = NB * SEQ;
constexpr int CROWS = NB * CTX;
constexpr int ROWS = XROWS + CROWS;
constexpr int NCOND = NB + 1;
constexpr float EPS = 1e-6f;

constexpr size_t MiB = 1u << 20;
constexpr size_t OFF_W1 = 0;
constexpr size_t SZ_W1 = (size_t)5632 * 1024 * 2;
constexpr size_t OFF_W2 = 44 * MiB;
constexpr size_t SZ_W2 = (size_t)1024 * 2816 * 2;
constexpr size_t OFF_RGIN = 66 * MiB;
constexpr size_t OFF_WG = 70 * MiB;
constexpr size_t OFF_RGOUT = 72 * MiB;
constexpr size_t OFF_QKV = 76 * MiB;
constexpr size_t OFF_WO = 79 * MiB;
constexpr size_t OFF_MOD = 81 * MiB;
constexpr size_t OFF_SSQ = 84 * MiB;
constexpr size_t OFF_ROPE = 86 * MiB;
constexpr size_t OFF_SPW = 86 * MiB + 65536;
constexpr size_t OFF_HC = 87 * MiB;
constexpr size_t OFF_R0 = 119 * MiB;
constexpr size_t SZ_R = 144 * MiB;
constexpr size_t OFF_R1 = OFF_R0 + SZ_R, OFF_R2 = OFF_R1 + SZ_R, OFF_R3 = OFF_R2 + SZ_R, OFF_R4 = OFF_R3 + SZ_R;
constexpr size_t WS_END = OFF_R4 + 2 * SZ_R;

struct Params {
    const float *x, *c, *ctx, *c_ctx, *w_mod, *b_mod, *norm_g, *ffn_w_in, *ffn_w_out, *rg_w_in, *rg_conv_w, *rg_conv_b, *rg_gate_w, *rg_gate_b,
        *rg_lambda, *rg_w_out, *attn_w_qkv, *attn_w_o, *attn_sink;
    float* out;
    char* ws;
    long long ph_lo, ph_hi;
};

__device__ __forceinline__ unsigned cvt_pk_bf16(float lo, float hi) { unsigned r; asm("v_cvt_pk_bf16_f32 %0, %1, %2" : "=v"(r) : "v"(lo), "v"(hi)); return r; }
__device__ __forceinline__ float bf_lo(unsigned w) { return __uint_as_float(w << 16); }
__device__ __forceinline__ float bf_hi(unsigned w) { return __uint_as_float(w & 0xffff0000u); }
__device__ __forceinline__ float sigmoidf_(float v) { return __builtin_amdgcn_rcpf(1.0f + __expf(-v)); }

__device__ __forceinline__ int lds_byte(int r, int c) { const int st = (r >> 4) * 2 + (c >> 5), ob = (r & 15) * 64 + (c & 31) * 2; return st * 1024 + (ob ^ (((ob >> 9) & 1) << 5)); }
__device__ __forceinline__ void stage_rc(int b, int& R, int& C) { const int st = b >> 10, sb = b & 1023, swz = sb ^ (((sb >> 9) & 1) << 5); R = (st >> 1) * 16 + swz / 64; C = (st & 1) * 32 + (swz % 64) / 2; }

constexpr int TILE_B = 256 * 64 * 2, STAGE_B = 2 * TILE_B;

template <bool GATE, class Epi>
__device__ __forceinline__ void gemm_phase(LAS char* shm, const bf16_t* A, int lda, const bf16_t* Bt, int ldb, int nM, int nN, int K, const Epi& epi) {
    const int tid = threadIdx.x, wid = tid >> 6, lane = tid & 63, wr = wid >> 2, wc = wid & 3, fr = lane & 15, fq = lane >> 4;
    unsigned offA[4], offB[4];
#pragma unroll
    for (int i = 0; i < 4; ++i) { int R, C; stage_rc(wid * 1024 + i * 8192 + lane * 16, R, C); offA[i] = (unsigned)(R * lda + C); offB[i] = (unsigned)(R * ldb + C); }
    const int lane_off = lds_byte(fr, fq * 8);
    const int nwg = nM * nN, G = gridDim.x, nt = K / 64;
    for (int L = blockIdx.x; L < nwg; L += G) {
        int wgid = L;
        { const int q = nwg / 8, r = nwg % 8, xcd = wgid % 8, off = wgid / 8; wgid = (xcd < r ? xcd * (q + 1) : r * (q + 1) + (xcd - r) * q) + off; }
        const int nig = 8 * nN, gid = wgid / nig, fm = gid * 8, gsz = (nM - fm) < 8 ? (nM - fm) : 8;
        const int pm = fm + ((wgid % nig) % gsz), pn = (wgid % nig) / gsz;
        const bf16_t* Ab = A + (size_t)pm * 256 * lda + (GATE ? (pn >> 1) * 256 : 0);
        const bf16_t* Bb = Bt + (size_t)pn * 256 * ldb;
        f32x4 acc[8][4];
#pragma unroll
        for (int m = 0; m < 8; ++m)
#pragma unroll
            for (int n = 0; n < 4; ++n) acc[m][n] = (f32x4){0.f, 0.f, 0.f, 0.f};
#define GEMM_STAGE(buf, kt) do { _Pragma("unroll") for (int i = 0; i < 4; ++i) { \
            __builtin_amdgcn_global_load_lds((const unsigned*)(Ab + offA[i] + (kt) * 64), (LAS unsigned*)(shm + (buf) * STAGE_B + wid * 1024 + i * 8192), 16, 0, 0); \
            __builtin_amdgcn_global_load_lds((const unsigned*)(Bb + offB[i] + (kt) * 64), (LAS unsigned*)(shm + (buf) * STAGE_B + TILE_B + wid * 1024 + i * 8192), 16, 0, 0); } } while (0)
        GEMM_STAGE(0, 0);
        asm volatile("s_waitcnt vmcnt(0)" ::: "memory");
        __syncthreads();
        for (int t = 0; t < nt; ++t) {
            const int cur = t & 1;
            if (t + 1 < nt) GEMM_STAGE(cur ^ 1, t + 1);
#pragma unroll
            for (int ks = 0; ks < 2; ++ks) {
                bf16x8 At[8], Bf[4];
#pragma unroll
                for (int m = 0; m < 8; ++m) At[m] = *(const LAS bf16x8*)(shm + cur * STAGE_B + ((wr * 8 + m) * 2 + ks) * 1024 + lane_off);
#pragma unroll
                for (int n = 0; n < 4; ++n) Bf[n] = *(const LAS bf16x8*)(shm + cur * STAGE_B + TILE_B + ((wc * 4 + n) * 2 + ks) * 1024 + lane_off);
#pragma unroll
                for (int m = 0; m < 8; ++m)
#pragma unroll
                    for (int n = 0; n < 4; ++n) acc[m][n] = __builtin_amdgcn_mfma_f32_16x16x32_bf16(Bf[n], At[m], acc[m][n], 0, 0, 0);
                __builtin_amdgcn_sched_barrier(0);
            }
            asm volatile("s_waitcnt vmcnt(0)" ::: "memory");
            __syncthreads();
        }
#undef GEMM_STAGE
        epi(acc, pm, pn, wr, wc, fr, fq, shm);
    }
}

struct EpiSwiglu {
    bf16_t* H;
    __device__ __forceinline__ void operator()(f32x4 (&acc)[8][4], int pm, int pn, int wr, int wc, int fr, int fq, LAS char*) const {
        const unsigned o0 = (unsigned)(pm * 256 + wr * 128 + fr) * DFF + pn * 128 + wc * 32 + fq * 4;
#pragma unroll
        for (int m = 0; m < 8; ++m) {
#pragma unroll
            for (int n = 0; n < 2; ++n) {
                const f32x4 g = acc[m][n], u = acc[m][n + 2];
                f32x4 v;
#pragma unroll
                for (int j = 0; j < 4; ++j) v[j] = g[j] * sigmoidf_(g[j]) * u[j];
                u32x2 w; w.x = cvt_pk_bf16(v[0], v[1]); w.y = cvt_pk_bf16(v[2], v[3]);
                *(u32x2*)(H + (o0 + (unsigned)(m * 16 * DFF + n * 16))) = w;
            }
            asm volatile("" ::: "memory");
        }
    }
};
struct EpiY {
    bf16_t* Y; float* ssq;
    __device__ __forceinline__ void operator()(f32x4 (&acc)[8][4], int pm, int pn, int wr, int wc, int fr, int fq, LAS char* shm) const {
        LAS float* red = (LAS float*)shm;
        if (threadIdx.x < 256) red[threadIdx.x] = 0.f;
        __syncthreads();
        const unsigned o0 = (unsigned)(pm * 256 + wr * 128 + fr) * DM + pn * 256 + wc * 64 + fq * 4;
#pragma unroll
        for (int m = 0; m < 8; ++m) {
            float s = 0.f;
#pragma unroll
            for (int n = 0; n < 4; ++n) {
                const f32x4 v = acc[m][n];
                s += (v[0] * v[0] + v[1] * v[1]) + (v[2] * v[2] + v[3] * v[3]);
                u32x2 w; w.x = cvt_pk_bf16(v[0], v[1]); w.y = cvt_pk_bf16(v[2], v[3]);
                *(u32x2*)(Y + (o0 + (unsigned)(m * 16 * DM + n * 16))) = w;
            }
            s += __shfl_xor(s, 16); s += __shfl_xor(s, 32);
            if (fq == 0) atomicAdd((float*)(red + wr * 128 + m * 16 + fr), s);
            asm volatile("" ::: "memory");
        }
        __syncthreads();
        if (threadIdx.x < 256) atomicAdd(ssq + pm * 256 + threadIdx.x, red[threadIdx.x]);
        __syncthreads();
    }
};
struct EpiRgIn {
    bf16_t* GX; bf16_t* XR;
    __device__ __forceinline__ void operator()(f32x4 (&acc)[8][4], int pm, int pn, int wr, int wc, int fr, int fq, LAS char*) const {
        const bool isg = pn < 4;
        bf16_t* base = isg ? GX : XR;
        const unsigned o0 = (unsigned)(pm * 256 + wr * 128 + fr) * DM + (pn & 3) * 256 + wc * 64 + fq * 4;
#pragma unroll
        for (int m = 0; m < 8; ++m) {
#pragma unroll
            for (int n = 0; n < 4; ++n) {
                f32x4 v = acc[m][n];
                if (isg) {
#pragma unroll
                    for (int j = 0; j < 4; ++j) { const float t = v[j], u2 = 1.5957691216f * (t + 0.044715f * t * t * t); v[j] = t * sigmoidf_(u2); }
                }
                u32x2 w; w.x = cvt_pk_bf16(v[0], v[1]); w.y = cvt_pk_bf16(v[2], v[3]);
                *(u32x2*)(base + (o0 + (unsigned)(m * 16 * DM + n * 16))) = w;
            }
            asm volatile("" ::: "memory");
        }
    }
};
struct EpiGate {
    const bf16_t* RX; unsigned* AB; const float* gb_r; const float* gb_i; const float* spw;
    __device__ __forceinline__ void operator()(f32x4 (&acc)[8][4], int pm, int pn, int wr, int wc, int fr, int fq, LAS char*) const {
        const int cb = (pn >> 1) * 256 + (pn & 1) * 128 + wc * 32 + fq * 4;
        f32x4 br[2], bi[2], sp[2];
#pragma unroll
        for (int n = 0; n < 2; ++n) { br[n] = *(const f32x4*)(gb_r + cb + n * 16); bi[n] = *(const f32x4*)(gb_i + cb + n * 16); sp[n] = *(const f32x4*)(spw + cb + n * 16); }
        const unsigned o0 = (unsigned)(pm * 256 + wr * 128 + fr) * DM + cb;
#pragma unroll
        for (int m = 0; m < 8; ++m) {
#pragma unroll
            for (int n = 0; n < 2; ++n) {
                const unsigned ro = o0 + (unsigned)(m * 16 * DM + n * 16);
                const u32x2 xw = *(const u32x2*)(RX + ro);
                const float xv[4] = {bf_lo(xw.x), bf_hi(xw.x), bf_lo(xw.y), bf_hi(xw.y)};
                u32x4 o;
#pragma unroll
                for (int j = 0; j < 4; ++j) {
                    const float r = sigmoidf_(acc[m][n][j] + br[n][j]), ig = sigmoidf_(acc[m][n + 2][j] + bi[n][j]);
                    const float la = sp[n][j] * r, x2 = 2.0f * la;
                    const float om = x2 > -0.1f ? -x2 * (1.0f + x2 * (0.5f + x2 * (0.16666667f + x2 * 0.041666667f))) : 1.0f - __expf(x2);
                    const float mult = __builtin_amdgcn_sqrtf(fmaxf(om, 0.f));
                    o[j] = cvt_pk_bf16(la, mult * ig * xv[j]);
                }
                *(u32x4*)(AB + ro) = o;
            }
            asm volatile("" ::: "memory");
        }
    }
};
struct EpiQkv {
    bf16_t* Q; bf16_t* Kb; bf16_t* Vt; bf16_t* Vtc; const float* rope;
    __device__ __forceinline__ void operator()(f32x4 (&acc)[8][4], int pm, int pn, int wr, int wc, int fr, int fq, LAS char*) const {
        const bool latent = pm < 256;
        if (pn < 5) {
            if (pn < 4 && !latent) return;
            const float sc = pn < 4 ? 0.125f : 1.0f;
#pragma unroll
            for (int m = 0; m < 8; ++m) {
                const int row = pm * 256 + wr * 128 + m * 16 + fr;
                f32x4 v0 = acc[m][0], v1 = acc[m][1], v2 = acc[m][2], v3 = acc[m][3];
                if (latent) {
                    const int t = row & 2047, gr = t >> 6, gc = t & 63;
                    const f32x4 ra = *(const f32x4*)(rope + (gr * 16 + fq * 4) * 2), rb = *(const f32x4*)(rope + (gr * 16 + fq * 4) * 2 + 4);
                    const f32x4 ca = *(const f32x4*)(rope + (gc * 16 + fq * 4) * 2), cb = *(const f32x4*)(rope + (gc * 16 + fq * 4) * 2 + 4);
                    const float rc[4] = {ra[0], ra[2], rb[0], rb[2]}, rs[4] = {ra[1], ra[3], rb[1], rb[3]};
                    const float cc[4] = {ca[0], ca[2], cb[0], cb[2]}, cs[4] = {ca[1], ca[3], cb[1], cb[3]};
#pragma unroll
                    for (int j = 0; j < 4; ++j) {
                        const float a1 = v0[j], a2 = v1[j]; v0[j] = a1 * rc[j] - a2 * rs[j]; v1[j] = a2 * rc[j] + a1 * rs[j];
                        const float b1 = v2[j], b2 = v3[j]; v2[j] = b1 * cc[j] - b2 * cs[j]; v3[j] = b2 * cc[j] + b1 * cs[j];
                    }
                }
                v0 *= sc; v1 *= sc; v2 *= sc; v3 *= sc;
                bf16_t* rp = (pn < 4) ? Q + (size_t)row * 1024 + pn * 256 + wc * 64 + fq * 4 : Kb + (size_t)row * 256 + wc * 64 + fq * 4;
                u32x2 w;
                w.x = cvt_pk_bf16(v0[0], v0[1]); w.y = cvt_pk_bf16(v0[2], v0[3]); *(u32x2*)(rp) = w;
                w.x = cvt_pk_bf16(v1[0], v1[1]); w.y = cvt_pk_bf16(v1[2], v1[3]); *(u32x2*)(rp + 16) = w;
                w.x = cvt_pk_bf16(v2[0], v2[1]); w.y = cvt_pk_bf16(v2[2], v2[3]); *(u32x2*)(rp + 32) = w;
                w.x = cvt_pk_bf16(v3[0], v3[1]); w.y = cvt_pk_bf16(v3[2], v3[3]); *(u32x2*)(rp + 48) = w;
            }
        } else {
#pragma unroll
            for (int m = 0; m < 8; ++m) {
                const int row = pm * 256 + wr * 128 + m * 16 + fr;
                bf16_t* vp; int stride;
                if (latent) { const int b = row >> 11, t = row & 2047; vp = Vt + ((size_t)(b * 4 + wc) * 64) * 2048 + t; stride = 2048; }
                else { const int rc_ = row - XROWS, b = rc_ >> 8, t = rc_ & 255; vp = Vtc + ((size_t)(b * 4 + wc) * 64) * 256 + t; stride = 256; }
#pragma unroll
                for (int n = 0; n < 4; ++n) {
                    const unsigned w0 = cvt_pk_bf16(acc[m][n][0], acc[m][n][1]), w1 = cvt_pk_bf16(acc[m][n][2], acc[m][n][3]);
                    bf16_t* dp = vp + (size_t)(n * 16 + fq * 4) * stride;
                    dp[0] = (bf16_t)(w0 & 0xffff); dp[stride] = (bf16_t)(w0 >> 16); dp[2 * stride] = (bf16_t)(w1 & 0xffff); dp[3 * stride] = (bf16_t)(w1 >> 16);
                }
            }
        }
    }
};

template <class ColPtr>
__device__ __forceinline__ void conv_t(LAS float* tile, int K, int Nout, int lds, bf16_t* dst, int ldd, ColPtr colptr) {
    const int tilesK = K / 64, nt = tilesK * (Nout / 64);
    const int rr = threadIdx.x & 63, kk = threadIdx.x >> 6, r = threadIdx.x >> 3, kc = (threadIdx.x & 7) * 8;
    for (int t = blockIdx.x; t < nt; t += gridDim.x) {
        const int tk = t % tilesK, tn = t / tilesK;
        const float* sp = colptr(tn * 64 + rr) + (size_t)(tk * 64 + kk * 8) * lds;
        float v[8];
#pragma unroll
        for (int i = 0; i < 8; ++i) v[i] = sp[(size_t)i * lds];
#pragma unroll
        for (int i = 0; i < 8; ++i) tile[rr * 65 + kk * 8 + i] = v[i];
        __syncthreads();
        float o[8];
#pragma unroll
        for (int i = 0; i < 8; ++i) o[i] = tile[r * 65 + kc + i];
        u32x4 w; w.x = cvt_pk_bf16(o[0], o[1]); w.y = cvt_pk_bf16(o[2], o[3]); w.z = cvt_pk_bf16(o[4], o[5]); w.w = cvt_pk_bf16(o[6], o[7]);
        *(u32x4*)(dst + (size_t)(tn * 64 + r) * ldd + tk * 64 + kc) = w;
        __syncthreads();
    }
}

__device__ __forceinline__ void prologue_phase(const Params& p, LAS char* shm) {
    const int tid = threadIdx.x, wid = tid >> 6, lane = tid & 63;
    const int gtid = blockIdx.x * 512 + tid, gsz = gridDim.x * 512;
    { float* ssq = (float*)(p.ws + OFF_SSQ); for (int i = gtid; i < 6 * ROWS; i += gsz) ssq[i] = 0.f; }
    if (gtid < 1024) {
        const int pos = gtid >> 4, i = gtid & 15;
        const float inv = exp2f(-(float)i * (13.287712379549449f / 16.0f));
        const float ang = (float)pos * inv;
        float* rt = (float*)(p.ws + OFF_ROPE);
        rt[gtid * 2] = __cosf(ang); rt[gtid * 2 + 1] = __sinf(ang);
    }
    if (gtid >= 1024 && gtid < 1024 + 2 * DM) { const int i = gtid - 1024; ((float*)(p.ws + OFF_SPW))[i] = -8.0f * log1pf(__expf(-p.rg_lambda[i])); }
    {
        LAS float* S = (LAS float*)shm;
        float* MOD = (float*)(p.ws + OFF_MOD);
        for (int it = blockIdx.x; it < 2 * 144; it += gridDim.x) {
            const int layer = it / 144, col0 = (it % 144) * 64;
            float acc[NCOND];
#pragma unroll
            for (int cn = 0; cn < NCOND; ++cn) acc[cn] = 0.f;
            for (int half = 0; half < 2; ++half) {
                __syncthreads();
                for (int idx = tid; idx < NCOND * 512; idx += 512) {
                    const int cn = idx >> 9, k = idx & 511;
                    const float v = cn < NB ? p.c[cn * DM + half * 512 + k] : p.c_ctx[half * 512 + k];
                    S[idx] = v / (1.0f + __expf(-v));
                }
                __syncthreads();
                const float* wp = p.w_mod + (size_t)layer * DM * (NMOD * DM) + (size_t)(half * 512 + wid * 64) * (NMOD * DM) + col0 + lane;
                for (int kb = 0; kb < 64; kb += 4) {
                    const float w0 = wp[(size_t)(kb + 0) * (NMOD * DM)], w1 = wp[(size_t)(kb + 1) * (NMOD * DM)], w2 = wp[(size_t)(kb + 2) * (NMOD * DM)], w3 = wp[(size_t)(kb + 3) * (NMOD * DM)];
#pragma unroll
                    for (int cn = 0; cn < NCOND; ++cn) {
                        const f32x4 s = *(const LAS f32x4*)(S + cn * 512 + wid * 64 + kb);
                        acc[cn] += (w0 * s[0] + w1 * s[1]) + (w2 * s[2] + w3 * s[3]);
                    }
                }
            }
            __syncthreads();
#pragma unroll
            for (int cn = 0; cn < NCOND; ++cn) S[(wid * NCOND + cn) * 64 + lane] = acc[cn];
            __syncthreads();
            for (int idx = tid; idx < NCOND * 64; idx += 512) {
                const int cn = idx >> 6, l = idx & 63;
                float s = p.b_mod[layer * (NMOD * DM) + col0 + l];
#pragma unroll
                for (int w = 0; w < 8; ++w) s += S[(w * NCOND + cn) * 64 + l];
                MOD[(size_t)(layer * NCOND + cn) * (NMOD * DM) + col0 + l] = s;
            }
        }
        __syncthreads();
    }
    LAS float* tile = (LAS float*)shm;
    for (int i = 0; i < 4; ++i) {
        const float* src = p.ffn_w_in + (size_t)i * DM * (2 * DFF);
        conv_t(tile, DM, 2 * DFF, 2 * DFF, (bf16_t*)(p.ws + OFF_W1 + i * SZ_W1), DM, [=](int r) {
            const int pn = r >> 8, q = r & 255, wc = q >> 6, part = (q >> 5) & 1, jj = q & 31;
            return src + part * DFF + pn * 128 + wc * 32 + jj; });
    }
    for (int i = 0; i < 4; ++i) {
        const float* src = p.ffn_w_out + (size_t)i * DFF * DM;
        conv_t(tile, DFF, DM, DM, (bf16_t*)(p.ws + OFF_W2 + i * SZ_W2), DFF, [=](int r) { return src + r; });
    }
    { const float* src = p.rg_w_in; conv_t(tile, DM, 2 * DM, 2 * DM, (bf16_t*)(p.ws + OFF_RGIN), DM, [=](int r) { return src + r; }); }
    { const float* src = p.rg_gate_w;
      conv_t(tile, 256, 4096, 256, (bf16_t*)(p.ws + OFF_WG), 256, [=](int r) {
          const int d = r >> 11, n = (r >> 9) & 3, half = (r >> 8) & 1, q = r & 255, wc = q >> 6, g = (q >> 5) & 1, jj = q & 31;
          return src + (size_t)(((d * 2 + g) * 4 + n) * 65536) + half * 128 + wc * 32 + jj; }); }
    for (int kh = 0; kh < 2; ++kh) { const float* src = p.rg_w_out; conv_t(tile, DM, DM, DM, (bf16_t*)(p.ws + OFF_RGOUT) + kh * DM, 2 * DM, [=](int r) { return src + r; }); }
    { const float* src = p.attn_w_qkv; conv_t(tile, DM, 1536, 1536, (bf16_t*)(p.ws + OFF_QKV), DM, [=](int r) { return src + r; }); }
    { const float* src = p.attn_w_o; conv_t(tile, DM, DM, DM, (bf16_t*)(p.ws + OFF_WO), DM, [=](int r) { return src + r; }); }
}

struct NMArgs {
    const float* hsrc_x; const float* hsrc_c; float* hdst_x; float* hdst_c;
    const bf16_t* Y; const float* ssq; const float* gate_mod; const float* gpost; float coef; int has_pending;
    const float* gpre; const float* shift_mod; const float* scale_mod; int has_next; bf16_t* Aout; int nrows;
};
__device__ __forceinline__ void nm_phase(const NMArgs& a) {
    const int lane = threadIdx.x & 63, wid = threadIdx.x >> 6;
    for (int row = blockIdx.x * 8 + wid; row < a.nrows; row += gridDim.x * 8) {
        const bool lat = row < XROWS;
        const int cn = lat ? (row >> 11) : NB;
        const float* hs = lat ? a.hsrc_x + (size_t)row * DM : a.hsrc_c + (size_t)(row - XROWS) * DM;
        f32x4 h[4];
#pragma unroll
        for (int ch = 0; ch < 4; ++ch) h[ch] = *(const f32x4*)(hs + ch * 256 + lane * 4);
        if (a.has_pending) {
            const float rstd = rsqrtf(a.ssq[row] * (1.0f / DM) + EPS) * a.coef;
            float* hd = lat ? a.hdst_x + (size_t)row * DM : a.hdst_c + (size_t)(row - XROWS) * DM;
#pragma unroll
            for (int ch = 0; ch < 4; ++ch) {
                const int e = ch * 256 + lane * 4;
                const u32x2 yw = *(const u32x2*)(a.Y + (size_t)row * DM + e);
                const f32x4 y = {bf_lo(yw.x), bf_hi(yw.x), bf_lo(yw.y), bf_hi(yw.y)};
                const f32x4 gm = *(const f32x4*)(a.gate_mod + (size_t)cn * (NMOD * DM) + e), gp = *(const f32x4*)(a.gpost + e);
                h[ch] += gm * ((y * rstd) * gp);
                *(f32x4*)(hd + e) = h[ch];
            }
        }
        if (a.has_next) {
            float ss = 0.f;
#pragma unroll
            for (int ch = 0; ch < 4; ++ch) ss += (h[ch][0] * h[ch][0] + h[ch][1] * h[ch][1]) + (h[ch][2] * h[ch][2] + h[ch][3] * h[ch][3]);
#pragma unroll
            for (int o = 32; o >= 1; o >>= 1) ss += __shfl_xor(ss, o);
            const float rstd = rsqrtf(ss * (1.0f / DM) + EPS);
#pragma unroll
            for (int ch = 0; ch < 4; ++ch) {
                const int e = ch * 256 + lane * 4;
                const f32x4 g = *(const f32x4*)(a.gpre + e), sh = *(const f32x4*)(a.shift_mod + (size_t)cn * (NMOD * DM) + e), sc = *(const f32x4*)(a.scale_mod + (size_t)cn * (NMOD * DM) + e);
                const f32x4 v = ((h[ch] * rstd) * g) * (1.0f + sc) + sh;
                u32x2 w; w.x = cvt_pk_bf16(v[0], v[1]); w.y = cvt_pk_bf16(v[2], v[3]);
                *(u32x2*)(a.Aout + (size_t)row * DM + e) = w;
            }
        }
    }
}

__device__ __forceinline__ void conv_phase(const bf16_t* XR, bf16_t* RX, const float* cw, const float* cb) {
    const int total = ROWS * 128;
    for (int i = blockIdx.x * 512 + threadIdx.x; i < total; i += gridDim.x * 512) {
        const int row = i >> 7, c0 = (i & 127) * 8;
        int t, len;
        if (row < XROWS) { t = row & 2047; len = SEQ; } else { t = (row - XROWS) & 255; len = CTX; }
        float acc[8];
        { const f32x4 b0 = *(const f32x4*)(cb + c0), b1 = *(const f32x4*)(cb + c0 + 4);
          acc[0] = b0[0]; acc[1] = b0[1]; acc[2] = b0[2]; acc[3] = b0[3]; acc[4] = b1[0]; acc[5] = b1[1]; acc[6] = b1[2]; acc[7] = b1[3]; }
#pragma unroll
        for (int k = 0; k < 4; ++k) {
            const int tt = t + k - 2;
            if (tt >= 0 && tt < len) {
                const u32x4 xw = *(const u32x4*)(XR + (size_t)(row + k - 2) * DM + c0);
                const f32x4 w0 = *(const f32x4*)(cw + k * DM + c0), w1 = *(const f32x4*)(cw + k * DM + c0 + 4);
                acc[0] += w0[0] * bf_lo(xw.x); acc[1] += w0[1] * bf_hi(xw.x); acc[2] += w0[2] * bf_lo(xw.y); acc[3] += w0[3] * bf_hi(xw.y);
                acc[4] += w1[0] * bf_lo(xw.z); acc[5] += w1[1] * bf_hi(xw.z); acc[6] += w1[2] * bf_lo(xw.w); acc[7] += w1[3] * bf_hi(xw.w);
            }
        }
        u32x4 w; w.x = cvt_pk_bf16(acc[0], acc[1]); w.y = cvt_pk_bf16(acc[2], acc[3]); w.z = cvt_pk_bf16(acc[4], acc[5]); w.w = cvt_pk_bf16(acc[6], acc[7]);
        *(u32x4*)(RX + (size_t)row * DM + c0) = w;
    }
}

__device__ __forceinline__ void scan_phase(const unsigned* AB, const bf16_t* GX, bf16_t* A2, int dir) {
    const int lane = threadIdx.x & 63, wid = threadIdx.x >> 6;
    const int it = wid * gridDim.x + blockIdx.x;
    if (it >= NB * 16) return;
    const int b = it >> 4, c = (it & 15) * 64 + lane;
    constexpr int U = 32, NBATCH = (CTX + SEQ) / U;
    float h = 0.f;
    unsigned abn[U]; bf16_t gxn[U];
    auto rowof = [&](int bt) -> int {
        const int s = bt * U;
        if (s < CTX) return XROWS + b * CTX + (dir ? (CTX - 1 - s) : s);
        return b * SEQ + (dir ? (SEQ - 1 - (s - CTX)) : (s - CTX));
    };
    const int stp = dir ? -1 : 1;
    { const int r0 = rowof(0);
#pragma unroll
      for (int i = 0; i < U; ++i) { const size_t o = (size_t)(r0 + stp * i) * DM + c; abn[i] = AB[o]; gxn[i] = GX[o]; } }
    for (int bt = 0; bt < NBATCH; ++bt) {
        unsigned abc[U]; bf16_t gxc[U];
#pragma unroll
        for (int i = 0; i < U; ++i) { abc[i] = abn[i]; gxc[i] = gxn[i]; }
        const int r0 = rowof(bt);
        if (bt + 1 < NBATCH) {
            const int r1 = rowof(bt + 1);
#pragma unroll
            for (int i = 0; i < U; ++i) { const size_t o = (size_t)(r1 + stp * i) * DM + c; abn[i] = AB[o]; gxn[i] = GX[o]; }
        }
#pragma unroll
        for (int i = 0; i < U; ++i) {
            const float a = __expf(bf_lo(abc[i])), bb = bf_hi(abc[i]);
            h = a * h + bb;
            const float o = __uint_as_float((unsigned)gxc[i] << 16) * h;
            A2[(size_t)(r0 + stp * i) * (2 * DM) + dir * DM + c] = (bf16_t)(cvt_pk_bf16(o, 0.f) & 0xffff);
        }
    }
}

__device__ __forceinline__ void attn_phase(const bf16_t* Q, const bf16_t* Kb, const bf16_t* Vt, const bf16_t* Vtc, const float* sink, bf16_t* O) {
    const int lane = threadIdx.x & 63, wid = threadIdx.x >> 6, fr = lane & 15, fq = lane >> 4;
    for (int it = blockIdx.x * 8 + wid; it < NB * 4 * 128; it += gridDim.x * 8) {
        const int qt = it & 127, kh = (it >> 7) & 3, b = it >> 9, q0 = qt * 16, qpos = q0 + fr;
        bf16x8 qf[4][2];
        { const bf16_t* qp = Q + (size_t)(b * SEQ + q0 + fr) * DM + kh * 256 + fq * 8;
#pragma unroll
          for (int g = 0; g < 4; ++g)
#pragma unroll
              for (int ks = 0; ks < 2; ++ks) qf[g][ks] = *(const bf16x8*)(qp + g * 64 + ks * 32); }
        float mrun[4], lrun[4]; f32x4 o[4][4];
#pragma unroll
        for (int g = 0; g < 4; ++g) { mrun[g] = sink[kh * 4 + g]; lrun[g] = 1.0f;
#pragma unroll
            for (int dt = 0; dt < 4; ++dt) o[g][dt] = (f32x4){0.f, 0.f, 0.f, 0.f}; }
        const int ks0 = (q0 & ~31) - 128;
        for (int bi = 0; bi < 17; ++bi) {
            const bool isctx = bi >= 9;
            int kbs, vstride; const bf16_t* kp; const bf16_t* vp;
            if (!isctx) {
                kbs = ks0 + bi * 32; if (kbs < 0 || kbs >= SEQ) continue;
                kp = Kb + (size_t)(b * SEQ + kbs + fr) * 256 + kh * 64 + fq * 8; vp = Vt + ((size_t)(b * 4 + kh) * 64 + fr) * SEQ + kbs + fq * 4; vstride = SEQ;
            } else {
                kbs = (bi - 9) * 32;
                kp = Kb + (size_t)(XROWS + b * CTX + kbs + fr) * 256 + kh * 64 + fq * 8; vp = Vtc + ((size_t)(b * 4 + kh) * 64 + fr) * CTX + kbs + fq * 4; vstride = CTX;
            }
            bf16x8 kf[2][2];
#pragma unroll
            for (int tl = 0; tl < 2; ++tl)
#pragma unroll
                for (int ks = 0; ks < 2; ++ks) kf[tl][ks] = *(const bf16x8*)(kp + tl * 16 * 256 + ks * 32);
            bf16x8 vf[4];
#pragma unroll
            for (int dt = 0; dt < 4; ++dt) {
                const u32x2 lo = *(const u32x2*)(vp + (size_t)dt * 16 * vstride), hi = *(const u32x2*)(vp + (size_t)dt * 16 * vstride + 16);
                u32x4 w; w.x = lo.x; w.y = lo.y; w.z = hi.x; w.w = hi.y;
                vf[dt] = __builtin_bit_cast(bf16x8, w);
            }
#pragma unroll
            for (int g = 0; g < 4; ++g) {
                f32x4 s0 = {0.f, 0.f, 0.f, 0.f}, s1 = {0.f, 0.f, 0.f, 0.f};
                s0 = __builtin_amdgcn_mfma_f32_16x16x32_bf16(kf[0][0], qf[g][0], s0, 0, 0, 0);
                s0 = __builtin_amdgcn_mfma_f32_16x16x32_bf16(kf[0][1], qf[g][1], s0, 0, 0, 0);
                s1 = __builtin_amdgcn_mfma_f32_16x16x32_bf16(kf[1][0], qf[g][0], s1, 0, 0, 0);
                s1 = __builtin_amdgcn_mfma_f32_16x16x32_bf16(kf[1][1], qf[g][1], s1, 0, 0, 0);
                if (!isctx) {
#pragma unroll
                    for (int j = 0; j < 4; ++j) {
                        const int d0 = kbs + fq * 4 + j - qpos, d1 = d0 + 16;
                        if (d0 > 128 || d0 < -128) s0[j] = -1e30f;
                        if (d1 > 128 || d1 < -128) s1[j] = -1e30f;
                    }
                }
                float mx = fmaxf(fmaxf(fmaxf(s0[0], s0[1]), fmaxf(s0[2], s0[3])), fmaxf(fmaxf(s1[0], s1[1]), fmaxf(s1[2], s1[3])));
                mx = fmaxf(mx, __shfl_xor(mx, 16)); mx = fmaxf(mx, __shfl_xor(mx, 32));
                const float mnew = fmaxf(mrun[g], mx), alpha = __expf(mrun[g] - mnew);
                mrun[g] = mnew;
                float p0[4], p1[4], ls = 0.f;
#pragma unroll
                for (int j = 0; j < 4; ++j) { p0[j] = __expf(s0[j] - mnew); p1[j] = __expf(s1[j] - mnew); ls += p0[j] + p1[j]; }
                ls += __shfl_xor(ls, 16); ls += __shfl_xor(ls, 32);
                lrun[g] = lrun[g] * alpha + ls;
                u32x4 pw; pw.x = cvt_pk_bf16(p0[0], p0[1]); pw.y = cvt_pk_bf16(p0[2], p0[3]); pw.z = cvt_pk_bf16(p1[0], p1[1]); pw.w = cvt_pk_bf16(p1[2], p1[3]);
                const bf16x8 pf = __builtin_bit_cast(bf16x8, pw);
#pragma unroll
                for (int dt = 0; dt < 4; ++dt) { o[g][dt] *= alpha; o[g][dt] = __builtin_amdgcn_mfma_f32_16x16x32_bf16(vf[dt], pf, o[g][dt], 0, 0, 0); }
            }
        }
#pragma unroll
        for (int g = 0; g < 4; ++g) {
            const float inv = 1.0f / lrun[g];
            bf16_t* op = O + (size_t)(b * SEQ + q0 + fr) * DM + (kh * 4 + g) * 64 + fq * 4;
#pragma unroll
            for (int dt = 0; dt < 4; ++dt) {
                const f32x4 v = o[g][dt] * inv;
                u32x2 w; w.x = cvt_pk_bf16(v[0], v[1]); w.y = cvt_pk_bf16(v[2], v[3]);
                *(u32x2*)(op + dt * 16) = w;
            }
        }
    }
}

constexpr int N_PHASES = 26;
enum { T_PRE, T_NM, T_W1, T_Y, T_RGIN, T_CONV, T_GATE, T_SCAN, T_QKV, T_ATTN };
struct PhaseDesc {
    int type = T_PRE;
    int nm_first = 0, nm_pl = 0, nm_pidx = 0, nm_pg = 0, nm_ssq = 0, nm_py3 = 0, nm_nl = 0, nm_nidx = 0, nm_ng = 0, nm_next = 1, nm_rows = ROWS; float nm_coef = 0.5f;
    int w_idx = 0, nM = ROWS / 256, ssq_i = 0, dir = 0, ykind = 0;
};
constexpr PhaseDesc phase_desc(int ph) {
    PhaseDesc d;
    switch (ph) {
        case 0: d.type = T_PRE; break;
        case 1: d.type = T_NM; d.nm_first = 1; d.nm_nl = 0; d.nm_nidx = 0; d.nm_ng = 0; break;
        case 2: d.type = T_W1; d.w_idx = 0; break;
        case 3: d.type = T_Y; d.ykind = 0; d.w_idx = 0; d.ssq_i = 0; break;
        case 4: d.type = T_NM; d.nm_pl = 0; d.nm_pidx = 2; d.nm_pg = 3; d.nm_ssq = 0; d.nm_nl = 0; d.nm_nidx = 3; d.nm_ng = 1; break;
        case 5: d.type = T_RGIN; break;
        case 6: d.type = T_CONV; break;
        case 7: d.type = T_GATE; d.dir = 0; break;
        case 8: d.type = T_SCAN; d.dir = 0; break;
        case 9: d.type = T_GATE; d.dir = 1; break;
        case 10: d.type = T_SCAN; d.dir = 1; break;
        case 11: d.type = T_Y; d.ykind = 1; d.ssq_i = 1; break;
        case 12: d.type = T_NM; d.nm_pl = 0; d.nm_pidx = 5; d.nm_pg = 4; d.nm_ssq = 1; d.nm_py3 = 1; d.nm_coef = 1.0f; d.nm_nl = 0; d.nm_nidx = 6; d.nm_ng = 2; break;
        case 13: d.type = T_W1; d.w_idx = 1; break;
        case 14: d.type = T_Y; d.ykind = 0; d.w_idx = 1; d.ssq_i = 2; break;
        case 15: d.type = T_NM; d.nm_pl = 0; d.nm_pidx = 8; d.nm_pg = 5; d.nm_ssq = 2; d.nm_nl = 1; d.nm_nidx = 0; d.nm_ng = 0; break;
        case 16: d.type = T_W1; d.w_idx = 2; break;
        case 17: d.type = T_Y; d.ykind = 0; d.w_idx = 2; d.ssq_i = 3; break;
        case 18: d.type = T_NM; d.nm_pl = 1; d.nm_pidx = 2; d.nm_pg = 3; d.nm_ssq = 3; d.nm_nl = 1; d.nm_nidx = 3; d.nm_ng = 1; break;
        case 19: d.type = T_QKV; break;
        case 20: d.type = T_ATTN; break;
        case 21: d.type = T_Y; d.ykind = 2; d.ssq_i = 4; d.nM = XROWS / 256; break;
        case 22: d.type = T_NM; d.nm_pl = 1; d.nm_pidx = 5; d.nm_pg = 4; d.nm_ssq = 4; d.nm_py3 = 1; d.nm_coef = 1.0f; d.nm_nl = 1; d.nm_nidx = 6; d.nm_ng = 2; d.nm_rows = XROWS; break;
        case 23: d.type = T_W1; d.w_idx = 3; d.nM = XROWS / 256; break;
        case 24: d.type = T_Y; d.ykind = 0; d.w_idx = 3; d.ssq_i = 5; d.nM = XROWS / 256; break;
        default: d.type = T_NM; d.nm_pl = 1; d.nm_pidx = 8; d.nm_pg = 5; d.nm_ssq = 5; d.nm_next = 0; d.nm_rows = XROWS; break;
    }
    return d;
}

#ifndef TMASK
#define TMASK 0x3ff
#endif
template <int PH>
__device__ __forceinline__ void run_phase(const Params& p, LAS char* shm) {
    constexpr PhaseDesc d = phase_desc(PH);
    if constexpr (((TMASK >> d.type) & 1) != 0) {
    char* ws = p.ws;
    bf16_t* R0 = (bf16_t*)(ws + OFF_R0); bf16_t* R1 = (bf16_t*)(ws + OFF_R1); bf16_t* R2 = (bf16_t*)(ws + OFF_R2); bf16_t* R3 = (bf16_t*)(ws + OFF_R3); bf16_t* R4 = (bf16_t*)(ws + OFF_R4);
    float* MOD = (float*)(ws + OFF_MOD); float* SSQ = (float*)(ws + OFF_SSQ); float* HC = (float*)(ws + OFF_HC);
    if constexpr (d.type == T_PRE) prologue_phase(p, shm);
    else if constexpr (d.type == T_NM) {
        NMArgs a;
        a.hsrc_x = (PH <= 4) ? p.x : p.out; a.hsrc_c = (PH <= 4) ? p.ctx : HC; a.hdst_x = p.out; a.hdst_c = HC;
        a.Y = d.nm_py3 ? R3 : R1; a.ssq = SSQ + (size_t)d.nm_ssq * ROWS;
        a.gate_mod = MOD + (size_t)d.nm_pl * NCOND * (NMOD * DM) + d.nm_pidx * DM; a.gpost = p.norm_g + (d.nm_pl * 6 + d.nm_pg) * DM; a.coef = d.nm_coef; a.has_pending = !d.nm_first;
        a.gpre = p.norm_g + (d.nm_nl * 6 + d.nm_ng) * DM; a.shift_mod = MOD + (size_t)d.nm_nl * NCOND * (NMOD * DM) + d.nm_nidx * DM; a.scale_mod = a.shift_mod + DM;
        a.has_next = d.nm_next; a.Aout = R0; a.nrows = d.nm_rows;
        nm_phase(a);
    } else if constexpr (d.type == T_W1) { EpiSwiglu e{R2}; gemm_phase<false>(shm, R0, DM, (const bf16_t*)(ws + OFF_W1 + d.w_idx * SZ_W1), DM, d.nM, 22, DM, e); }
    else if constexpr (d.type == T_Y) {
        if constexpr (d.ykind == 0) { EpiY e{R1, SSQ + (size_t)d.ssq_i * ROWS}; gemm_phase<false>(shm, R2, DFF, (const bf16_t*)(ws + OFF_W2 + d.w_idx * SZ_W2), DFF, d.nM, 4, DFF, e); }
        else if constexpr (d.ykind == 1) { EpiY e{R3, SSQ + (size_t)d.ssq_i * ROWS}; gemm_phase<false>(shm, R0, 2 * DM, (const bf16_t*)(ws + OFF_RGOUT), 2 * DM, d.nM, 4, 2 * DM, e); }
        else { EpiY e{R3, SSQ + (size_t)d.ssq_i * ROWS}; gemm_phase<false>(shm, R1, DM, (const bf16_t*)(ws + OFF_WO), DM, d.nM, 4, DM, e); }
    } else if constexpr (d.type == T_RGIN) { EpiRgIn e{R2, R1}; gemm_phase<false>(shm, R0, DM, (const bf16_t*)(ws + OFF_RGIN), DM, ROWS / 256, 8, DM, e); }
    else if constexpr (d.type == T_CONV) conv_phase(R1, R3, p.rg_conv_w, p.rg_conv_b);
    else if constexpr (d.type == T_GATE) {
        EpiGate e{R3, (unsigned*)R4, p.rg_gate_b + (d.dir * 2 + 0) * DM, p.rg_gate_b + (d.dir * 2 + 1) * DM, (const float*)(ws + OFF_SPW) + d.dir * DM};
        gemm_phase<true>(shm, R3, DM, (const bf16_t*)(ws + OFF_WG) + (size_t)d.dir * 8 * 65536, 256, ROWS / 256, 8, 256, e);
    } else if constexpr (d.type == T_SCAN) scan_phase((const unsigned*)R4, R2, R0, d.dir);
    else if constexpr (d.type == T_QKV) {
        EpiQkv e{R2, R4, (bf16_t*)(ws + OFF_R4 + 40 * MiB), (bf16_t*)(ws + OFF_R4 + 80 * MiB), (const float*)(ws + OFF_ROPE)};
        gemm_phase<false>(shm, R0, DM, (const bf16_t*)(ws + OFF_QKV), DM, ROWS / 256, 6, DM, e);
    } else if constexpr (d.type == T_ATTN) attn_phase(R2, R4, (const bf16_t*)(ws + OFF_R4 + 40 * MiB), (const bf16_t*)(ws + OFF_R4 + 80 * MiB), p.attn_sink, R1);
    }
}

template <int PH>
__device__ __forceinline__ void do_phase(const Params& p, LAS char* shm, cg::grid_group& grid) {
    if (PH >= (int)p.ph_lo && PH < (int)p.ph_hi) {
        if (PH > (int)p.ph_lo) grid.sync();
        run_phase<PH>(p, shm);
    }
}

__global__ void __launch_bounds__(512) fwd_megakernel(Params p) {
    __shared__ __attribute__((aligned(1024))) char shm_[2 * STAGE_B];
    LAS char* shm = (LAS char*)shm_;
    cg::grid_group grid = cg::this_grid();
    do_phase<0>(p, shm, grid); do_phase<1>(p, shm, grid); do_phase<2>(p, shm, grid); do_phase<3>(p, shm, grid); do_phase<4>(p, shm, grid);
    do_phase<5>(p, shm, grid); do_phase<6>(p, shm, grid); do_phase<7>(p, shm, grid); do_phase<8>(p, shm, grid); do_phase<9>(p, shm, grid);
    do_phase<10>(p, shm, grid); do_phase<11>(p, shm, grid); do_phase<12>(p, shm, grid); do_phase<13>(p, shm, grid); do_phase<14>(p, shm, grid);
    do_phase<15>(p, shm, grid); do_phase<16>(p, shm, grid); do_phase<17>(p, shm, grid); do_phase<18>(p, shm, grid); do_phase<19>(p, shm, grid);
    do_phase<20>(p, shm, grid); do_phase<21>(p, shm, grid); do_phase<22>(p, shm, grid); do_phase<23>(p, shm, grid); do_phase<24>(p, shm, grid);
    do_phase<25>(p, shm, grid);
}

extern "C" void kernel_launch(void* const* d_in, const int* in_sizes, int n_in, void* d_out, int out_size, void* d_ws, size_t ws_size, hipStream_t stream) {
    static int grid_blocks = 0;
    if (!grid_blocks) {
        int dev = 0, cus = 0, per_cu = 0;
        hipGetDevice(&dev);
        hipDeviceGetAttribute(&cus, hipDeviceAttributeMultiprocessorCount, dev);
        hipOccupancyMaxActiveBlocksPerMultiprocessor(&per_cu, fwd_megakernel, 512, 0);
        if (per_cu < 1) per_cu = 1;
        if (per_cu > 1) per_cu = 1;
        grid_blocks = cus * per_cu;
        if (grid_blocks % 8) grid_blocks -= grid_blocks % 8;
        if (ws_size < WS_END || n_in != 19) { fprintf(stderr, "kernel_launch: unexpected workspace %zu (< %zu) or n_in %d\n", ws_size, (size_t)WS_END, n_in); }
    }
    Params p{};
    const float** pp = (const float**)&p;
    for (int i = 0; i < 19; ++i) pp[i] = (const float*)d_in[i];
    p.out = (float*)d_out; p.ws = (char*)d_ws;
#if MK_MULTI
    for (int ph = 0; ph < N_PHASES; ++ph) {
        p.ph_lo = ph; p.ph_hi = ph + 1;
        hipLaunchKernelGGL(fwd_megakernel, dim3(grid_blocks), dim3(512), 0, stream, p);
    }
#else
    p.ph_lo = 0; p.ph_hi = N_PHASES;
    void* args[] = {&p};
    hipError_t e = hipLaunchCooperativeKernel((void*)fwd_megakernel, dim3(grid_blocks), dim3(512), args, 0, stream);
    if (e != hipSuccess) fprintf(stderr, "cooperative launch failed: %s (grid %d)\n", hipGetErrorString(e), grid_blocks);
#endif
}
```

```cpp
#include <hip/hip_runtime.h>
#include <hip/hip_cooperative_groups.h>
#include <cstdio>
#include <cstdint>
namespace cg = cooperative_groups;

#ifndef MK_MULTI
#define MK_MULTI 0
#endif

typedef unsigned short bf16_t;
typedef short bf16x8 __attribute__((ext_vector_type(8)));
typedef float f32x4 __attribute__((ext_vector_type(4)));
typedef float f32x2 __attribute__((ext_vector_type(2)));
typedef unsigned u32x2 __attribute__((ext_vector_type(2)));
typedef unsigned u32x4 __attribute__((ext_vector_type(4)));
#define LAS __attribute__((address_space(3)))

constexpr int DM = 1024, NB = 32, SEQ = 2048, CTX = 256, DFF = 2816, NMOD = 9;
constexpr int XROWS = NB * SEQ;
constexpr int CROWS = NB * CTX;
constexpr int ROWS = XROWS + CROWS;
constexpr int NCOND = NB + 1;
constexpr float EPS = 1e-6f;

constexpr size_t MiB = 1u << 20;
constexpr size_t OFF_W1 = 0;
constexpr size_t SZ_W1 = (size_t)5632 * 1024 * 2;
constexpr size_t OFF_W2 = 44 * MiB;
constexpr size_t SZ_W2 = (size_t)1024 * 2816 * 2;
constexpr size_t OFF_RGIN = 66 * MiB;
constexpr size_t OFF_WG = 70 * MiB;
constexpr size_t OFF_RGOUT = 72 * MiB;
constexpr size_t OFF_QKV = 76 * MiB;
constexpr size_t OFF_WO = 79 * MiB;
constexpr size_t OFF_MOD = 81 * MiB;
constexpr size_t OFF_SSQ = 984 * MiB;
constexpr size_t OFF_ROPE = 86 * MiB;
constexpr size_t OFF_SPW = 86 * MiB + 65536;
constexpr size_t OFF_HC = 87 * MiB;
constexpr size_t OFF_R0 = 119 * MiB;
constexpr size_t SZ_R = 144 * MiB;
constexpr size_t OFF_R1 = OFF_R0 + SZ_R, OFF_R2 = OFF_R1 + SZ_R, OFF_R3 = OFF_R2 + SZ_R, OFF_R4 = OFF_R3 + SZ_R;
constexpr size_t WS_END = 989 * MiB;

struct Params {
    const float *x, *c, *ctx, *c_ctx, *w_mod, *b_mod, *norm_g, *ffn_w_in, *ffn_w_out, *rg_w_in, *rg_conv_w, *rg_conv_b, *rg_gate_w, *rg_gate_b,
        *rg_lambda, *rg_w_out, *attn_w_qkv, *attn_w_o, *attn_sink;
    float* out;
    char* ws;
    long long ph_lo, ph_hi;
};

__device__ __forceinline__ unsigned cvt_pk_bf16(float lo, float hi) { unsigned r; asm("v_cvt_pk_bf16_f32 %0, %1, %2" : "=v"(r) : "v"(lo), "v"(hi)); return r; }
__device__ __forceinline__ float bf_lo(unsigned w) { return __uint_as_float(w << 16); }
__device__ __forceinline__ float bf_hi(unsigned w) { return __uint_as_float(w & 0xffff0000u); }
__device__ __forceinline__ float sigmoidf_(float v) { return __builtin_amdgcn_rcpf(1.0f + __expf(-v)); }

constexpr int HTB = 128 * 64 * 2, STAGE_BYTES = 8 * HTB;
__device__ __forceinline__ int lds_byte(int r, int c) { const int st = (r >> 4) * 2 + (c >> 5), rr = r & 15, cc = c & 31, ob = rr * 64 + cc * 2; return st * 1024 + (ob ^ (((ob >> 9) & 1) << 5)); }
__device__ __forceinline__ void stage_rc(int b, int& R, int& C) { const int st = b / 1024, sb = b % 1024, swz = sb ^ (((sb >> 9) & 1) << 5); R = (st >> 1) * 16 + swz / 64; C = (st & 1) * 32 + (swz % 64) / 2; }
struct Unit { int pm, pn; };
struct StaticOrder {
    int nM, nN, nwg, G, c;
    __device__ __forceinline__ void init(int nM_, int nN_, int G_, int c_) { nM = nM_; nN = nN_; nwg = nM * nN; G = G_; c = c_; }
    __device__ __forceinline__ bool next(int i, Unit& u) const {
        const long L = (long)i * G + c; if (L >= nwg) return false;
        int wgid = (int)L; { const int q = nwg / 8, r = nwg % 8, xcd = wgid % 8, off = wgid / 8; wgid = (xcd < r ? xcd * (q + 1) : r * (q + 1) + (xcd - r) * q) + off; }
        const int nig = 8 * nN, gid = wgid / nig, fm = gid * 8, gsz = (nM - fm) < 8 ? (nM - fm) : 8;
        u.pm = fm + ((wgid % nig) % gsz); u.pn = (wgid % nig) / gsz; return true;
    }
};

template <bool GATE, class Epi>
__device__ __forceinline__ void gemm_phase(LAS char* lds, const bf16_t* A, int lda, const bf16_t* Bt, int ldb, int nM, int nN, int K, const Epi& E) {
    const int tid = threadIdx.x, wid = __builtin_amdgcn_readfirstlane(tid >> 6), lane = tid & 63, wr = wid >> 2, wc = wid & 3, fr = lane & 15, fq = lane >> 4;
    const int nt = K / 64;
    StaticOrder S; S.init(nM, nN, gridDim.x, blockIdx.x);
    unsigned voffA[2], voffB[2];
#pragma unroll
    for (int i = 0; i < 2; ++i) { int R, C; stage_rc(tid * 16 + i * 8192, R, C); voffA[i] = (unsigned)(R * lda + C) * 2u; voffB[i] = (unsigned)(R * ldb + C) * 2u; }
    const size_t kstep = 128;
    const size_t hstepA = (size_t)128 * lda * 2, hstepB = (size_t)128 * ldb * 2;
    const size_t tstepA = 2 * hstepA, tstepB = 2 * hstepB;
    const unsigned ldsw = (unsigned)wid * 1024u;
    LAS char* ldsA = lds + lds_byte(wr * 64 + fr, fq * 8);
    LAS char* ldsB = lds + 4 * HTB + lds_byte(wc * 32 + fr, fq * 8);
    asm volatile("" : "+v"(ldsA), "+v"(ldsB));
#define PG8_SA(b, h) (((b) * 2 + (h)) * HTB)
#define PG8_SB(b, h) ((4 + (b) * 2 + (h)) * HTB)
#define PG8_STAGE(bufoff, gbase, voff) do { _Pragma("unroll") for (int _i = 0; _i < 2; ++_i) \
        __builtin_amdgcn_global_load_lds((const unsigned*)((const char*)(gbase) + (voff)[_i]), (LAS unsigned*)(lds + (bufoff) + ldsw + _i * 8192), 16, 0, 0); } while (0)
#define PG8_LDA(dst, b, h) do { _Pragma("unroll") for (int m = 0; m < 4; ++m) _Pragma("unroll") for (int k = 0; k < 2; ++k) dst[m][k] = *(const LAS bf16x8*)(ldsA + PG8_SA(b, h) + m * 2048 + k * 1024); } while (0)
#define PG8_LDB(dst, b, h) do { _Pragma("unroll") for (int n = 0; n < 2; ++n) _Pragma("unroll") for (int k = 0; k < 2; ++k) dst[n][k] = *(const LAS bf16x8*)(ldsB + ((b) * 2 + (h)) * HTB + n * 2048 + k * 1024); } while (0)
#define PG8_MMA(ai, bj, At, Bt_) do { __builtin_amdgcn_s_setprio(1); _Pragma("unroll") for (int m = 0; m < 4; ++m) _Pragma("unroll") for (int n = 0; n < 2; ++n) _Pragma("unroll") for (int k = 0; k < 2; ++k) \
        acc[ai][bj][m][n] = __builtin_amdgcn_mfma_f32_16x16x32_bf16(Bt_[n][k], At[m][k], acc[ai][bj][m][n], 0, 0, 0); __builtin_amdgcn_s_setprio(0); } while (0)
#define PG8_WAIT_V(n) asm volatile("s_waitcnt vmcnt(" #n ")" ::: "memory")
#define PG8_WAIT_L(n) asm volatile("s_waitcnt lgkmcnt(" #n ")" ::: "memory")
#define PG8_BAR __builtin_amdgcn_s_barrier()
#define PG8_SCHED __builtin_amdgcn_sched_barrier(0)
#define PG8_ABASE(u) ((const char*)A + (size_t)(u).pm * tstepA + (GATE ? (size_t)((u).pn >> 1) * 512 : 0))
#define PG8_BBASE(u) ((const char*)Bt + (size_t)(u).pn * tstepB)
    Unit cur, nxt; int ui = 0;
    if (!S.next(0, cur)) return;
    f32x4 acc[2][2][4][2];
#pragma unroll
    for (int a = 0; a < 2; ++a)
#pragma unroll
        for (int b = 0; b < 2; ++b)
#pragma unroll
            for (int m = 0; m < 4; ++m)
#pragma unroll
                for (int n = 0; n < 2; ++n) acc[a][b][m][n] = (f32x4){0.f, 0.f, 0.f, 0.f};
    bf16x8 At[4][2], B0[2][2], B1[2][2];
    const char* cA = PG8_ABASE(cur); const char* cB = PG8_BBASE(cur);
    PG8_STAGE(PG8_SB(0, 0), cB, voffB); PG8_STAGE(PG8_SB(0, 1), cB + hstepB, voffB); PG8_STAGE(PG8_SA(0, 0), cA, voffA); PG8_STAGE(PG8_SA(0, 1), cA + hstepA, voffA);
    if (wr == 1) PG8_BAR;
    PG8_WAIT_V(2); PG8_BAR;
    PG8_STAGE(PG8_SB(1, 0), cB + kstep, voffB); PG8_STAGE(PG8_SA(1, 0), cA + kstep, voffA); PG8_STAGE(PG8_SB(1, 1), cB + hstepB + kstep, voffB);
    PG8_WAIT_V(6); PG8_BAR;
    for (;;) {
        const bool has_next = S.next(ui + 1, nxt);
        const char* nA = has_next ? PG8_ABASE(nxt) : cA; const char* nB = has_next ? PG8_BBASE(nxt) : cB;
        for (int t = 0; t < nt; t += 2) {
            const bool last = (t == nt - 2);
            const char* a1 = cA + (size_t)(t + 1) * kstep;
            const char* a2 = last ? nA : cA + (size_t)(t + 2) * kstep; const char* b2 = last ? nB : cB + (size_t)(t + 2) * kstep;
            const char* a3 = a2 + kstep; const char* b3 = b2 + kstep;
            PG8_LDB(B0, 0, 0); PG8_LDB(B1, 0, 1); PG8_SCHED; PG8_LDA(At, 0, 0); PG8_STAGE(PG8_SA(1, 1), a1 + hstepA, voffA);
            PG8_WAIT_V(8); PG8_WAIT_L(0); PG8_BAR; PG8_MMA(0, 0, At, B0); PG8_MMA(0, 1, At, B1); PG8_BAR; PG8_SCHED;
            PG8_LDA(At, 0, 1); PG8_STAGE(PG8_SB(0, 0), b2, voffB); PG8_STAGE(PG8_SB(0, 1), b2 + hstepB, voffB); PG8_STAGE(PG8_SA(0, 0), a2, voffA);
            PG8_WAIT_V(8); PG8_WAIT_L(0); PG8_BAR; PG8_MMA(1, 0, At, B0); PG8_MMA(1, 1, At, B1); PG8_BAR; PG8_SCHED;
            PG8_LDB(B0, 1, 0); PG8_LDB(B1, 1, 1); PG8_SCHED; PG8_LDA(At, 1, 0); PG8_STAGE(PG8_SA(0, 1), a2 + hstepA, voffA);
            PG8_WAIT_V(8); PG8_WAIT_L(0); PG8_BAR; PG8_MMA(0, 0, At, B0); PG8_MMA(0, 1, At, B1); PG8_BAR; PG8_SCHED;
            PG8_LDA(At, 1, 1); PG8_STAGE(PG8_SB(1, 0), b3, voffB); PG8_STAGE(PG8_SB(1, 1), b3 + hstepB, voffB); PG8_STAGE(PG8_SA(1, 0), a3, voffA);
            PG8_WAIT_V(8); PG8_WAIT_L(0); PG8_BAR; PG8_MMA(1, 0, At, B0); PG8_MMA(1, 1, At, B1); PG8_BAR; PG8_SCHED;
        }
        if (wr == 0) PG8_BAR;
        E(acc, cur, wr, wc, fr, fq);
        if (!has_next) break;
#pragma unroll
        for (int a = 0; a < 2; ++a)
#pragma unroll
            for (int b = 0; b < 2; ++b)
#pragma unroll
                for (int m = 0; m < 4; ++m)
#pragma unroll
                    for (int n = 0; n < 2; ++n) acc[a][b][m][n] = (f32x4){0.f, 0.f, 0.f, 0.f};
        cur = nxt; cA = nA; cB = nB; ++ui;
        if (wr == 1) PG8_BAR;
    }
    PG8_WAIT_V(0);
    PG8_BAR;
#undef PG8_SA
#undef PG8_SB
#undef PG8_STAGE
#undef PG8_LDA
#undef PG8_LDB
#undef PG8_MMA
#undef PG8_WAIT_V
#undef PG8_WAIT_L
#undef PG8_BAR
#undef PG8_SCHED
#undef PG8_ABASE
#undef PG8_BBASE
}

typedef f32x4 Acc[2][2][4][2];
struct EpiSwiglu {
    bf16_t* H;
    __device__ __forceinline__ void operator()(Acc& acc, const Unit& u, int wr, int wc, int fr, int fq) const {
        const unsigned o0 = (unsigned)(u.pm * 256 + wr * 64 + fr) * DFF + u.pn * 128 + wc * 32 + fq * 4;
#pragma unroll
        for (int ai = 0; ai < 2; ++ai)
#pragma unroll
            for (int m = 0; m < 4; ++m) {
#pragma unroll
                for (int n = 0; n < 2; ++n) {
                    const f32x4 g = acc[ai][0][m][n], up = acc[ai][1][m][n];
                    f32x4 v;
#pragma unroll
                    for (int j = 0; j < 4; ++j) v[j] = g[j] * sigmoidf_(g[j]) * up[j];
                    u32x2 w; w.x = cvt_pk_bf16(v[0], v[1]); w.y = cvt_pk_bf16(v[2], v[3]);
                    *(u32x2*)(H + (o0 + (unsigned)((ai * 128 + m * 16) * DFF + n * 16))) = w;
                }
                asm volatile("" ::: "memory");
            }
    }
};
struct EpiY {
    bf16_t* Y; float* ssq;
    __device__ __forceinline__ void operator()(Acc& acc, const Unit& u, int wr, int wc, int fr, int fq) const {
        const unsigned r0 = (unsigned)(u.pm * 256 + wr * 64 + fr);
        const unsigned o0 = r0 * DM + u.pn * 256 + wc * 32 + fq * 4;
#pragma unroll
        for (int ai = 0; ai < 2; ++ai)
#pragma unroll
            for (int m = 0; m < 4; ++m) {
                float s = 0.f;
#pragma unroll
                for (int bj = 0; bj < 2; ++bj)
#pragma unroll
                    for (int n = 0; n < 2; ++n) {
                        const f32x4 v = acc[ai][bj][m][n];
                        s += (v[0] * v[0] + v[1] * v[1]) + (v[2] * v[2] + v[3] * v[3]);
                        u32x2 w; w.x = cvt_pk_bf16(v[0], v[1]); w.y = cvt_pk_bf16(v[2], v[3]);
                        *(u32x2*)(Y + (o0 + (unsigned)((ai * 128 + m * 16) * DM + bj * 128 + n * 16))) = w;
                    }
                s += __shfl_xor(s, 16); s += __shfl_xor(s, 32);
                if (fq == 0) ssq[(r0 + (unsigned)(ai * 128 + m * 16)) * 16 + u.pn * 4 + wc] = s;
                asm volatile("" ::: "memory");
            }
    }
};
struct EpiRgIn {
    bf16_t* GX; bf16_t* XR;
    __device__ __forceinline__ void operator()(Acc& acc, const Unit& u, int wr, int wc, int fr, int fq) const {
        const bool isg = u.pn < 4;
        bf16_t* base = isg ? GX : XR;
        const unsigned o0 = (unsigned)(u.pm * 256 + wr * 64 + fr) * DM + (u.pn & 3) * 256 + wc * 32 + fq * 4;
#pragma unroll
        for (int ai = 0; ai < 2; ++ai)
#pragma unroll
            for (int m = 0; m < 4; ++m) {
#pragma unroll
                for (int bj = 0; bj < 2; ++bj)
#pragma unroll
                    for (int n = 0; n < 2; ++n) {
                        f32x4 v = acc[ai][bj][m][n];
                        if (isg) {
#pragma unroll
                            for (int j = 0; j < 4; ++j) { const float t = v[j], u2 = 1.5957691216f * (t + 0.044715f * t * t * t); v[j] = t * sigmoidf_(u2); }
                        }
                        u32x2 w; w.x = cvt_pk_bf16(v[0], v[1]); w.y = cvt_pk_bf16(v[2], v[3]);
                        *(u32x2*)(base + (o0 + (unsigned)((ai * 128 + m * 16) * DM + bj * 128 + n * 16))) = w;
                    }
                asm volatile("" ::: "memory");
            }
    }
};
struct EpiGate {
    const bf16_t* RX; unsigned* AB; const float* gb_r; const float* gb_i; const float* spw;
    __device__ __forceinline__ void operator()(Acc& acc, const Unit& u, int wr, int wc, int fr, int fq) const {
        const int cb = (u.pn >> 1) * 256 + (u.pn & 1) * 128 + wc * 32 + fq * 4;
        const unsigned o0 = (unsigned)(u.pm * 256 + wr * 64 + fr) * DM + cb;
#pragma unroll
        for (int ai = 0; ai < 2; ++ai)
#pragma unroll
            for (int m = 0; m < 4; ++m) {
#pragma unroll
                for (int n = 0; n < 2; ++n) {
                    const unsigned ro = o0 + (unsigned)((ai * 128 + m * 16) * DM + n * 16);
                    const f32x4 brn = *(const f32x4*)(gb_r + cb + n * 16), bin = *(const f32x4*)(gb_i + cb + n * 16), spn = *(const f32x4*)(spw + cb + n * 16);
                    const u32x2 xw = *(const u32x2*)(RX + ro);
                    const float xv[4] = {bf_lo(xw.x), bf_hi(xw.x), bf_lo(xw.y), bf_hi(xw.y)};
                    u32x4 o;
#pragma unroll
                    for (int j = 0; j < 4; ++j) {
                        const float r = sigmoidf_(acc[ai][0][m][n][j] + brn[j]), ig = sigmoidf_(acc[ai][1][m][n][j] + bin[j]);
                        const float la = spn[j] * r, x2 = 2.0f * la;
                        const float om = x2 > -0.1f ? -x2 * (1.0f + x2 * (0.5f + x2 * (0.16666667f + x2 * 0.041666667f))) : 1.0f - __expf(x2);
                        const float mult = __builtin_amdgcn_sqrtf(fmaxf(om, 0.f));
                        o[j] = cvt_pk_bf16(la, mult * ig * xv[j]);
                    }
                    *(u32x4*)(AB + ro) = o;
                    asm volatile("" ::: "memory");
                }
            }
    }
};
struct EpiQkv {
    bf16_t* Q; bf16_t* Kb; bf16_t* Vt; bf16_t* Vtc; const float* rope;
    __device__ __forceinline__ void operator()(Acc& acc, const Unit& u, int wr, int wc, int fr, int fq) const {
        const bool latent = u.pm < 256;
        const int pn = u.pn;
        if (pn < 5) {
            if (pn < 4 && !latent) return;
            const float sc = pn < 4 ? 0.125f : 1.0f;
#pragma unroll
            for (int ai = 0; ai < 2; ++ai)
#pragma unroll
                for (int m = 0; m < 4; ++m) {
                    const int row = u.pm * 256 + ai * 128 + wr * 64 + m * 16 + fr;
                    float rc[4] = {1.f, 1.f, 1.f, 1.f}, rs[4] = {0.f, 0.f, 0.f, 0.f};
                    if (latent) {
                        const int t = row & 2047, pos = (wc & 1) ? (t & 63) : (t >> 6);
                        const f32x4 ra = *(const f32x4*)(rope + (pos * 16 + fq * 4) * 2), rb = *(const f32x4*)(rope + (pos * 16 + fq * 4) * 2 + 4);
                        rc[0] = ra[0]; rc[1] = ra[2]; rc[2] = rb[0]; rc[3] = rb[2]; rs[0] = ra[1]; rs[1] = ra[3]; rs[2] = rb[1]; rs[3] = rb[3];
                    }
                    bf16_t* rp = (pn < 4) ? Q + (size_t)row * 1024 + pn * 256 + wc * 32 + fq * 4 : Kb + (size_t)row * 256 + wc * 32 + fq * 4;
#pragma unroll
                    for (int bj = 0; bj < 2; ++bj) {
                        f32x4 v0 = acc[ai][bj][m][0], v1 = acc[ai][bj][m][1];
#pragma unroll
                        for (int j = 0; j < 4; ++j) { const float a1 = v0[j], a2 = v1[j]; v0[j] = (a1 * rc[j] - a2 * rs[j]) * sc; v1[j] = (a2 * rc[j] + a1 * rs[j]) * sc; }
                        u32x2 w;
                        w.x = cvt_pk_bf16(v0[0], v0[1]); w.y = cvt_pk_bf16(v0[2], v0[3]); *(u32x2*)(rp + bj * 128) = w;
                        w.x = cvt_pk_bf16(v1[0], v1[1]); w.y = cvt_pk_bf16(v1[2], v1[3]); *(u32x2*)(rp + bj * 128 + 16) = w;
                    }
                    asm volatile("" ::: "memory");
                }
        } else {
#pragma unroll
            for (int ai = 0; ai < 2; ++ai)
#pragma unroll
                for (int m = 0; m < 4; ++m) {
                    const int row = u.pm * 256 + ai * 128 + wr * 64 + m * 16 + fr;
                    bf16_t* vp; int stride;
                    if (latent) { const int b = row >> 11, t = row & 2047; vp = Vt + (size_t)(b * 4) * 64 * 2048 + t; stride = 2048; }
                    else { const int rc_ = row - XROWS, b = rc_ >> 8, t = rc_ & 255; vp = Vtc + (size_t)(b * 4) * 64 * 256 + t; stride = 256; }
#pragma unroll
                    for (int bj = 0; bj < 2; ++bj)
#pragma unroll
                        for (int n = 0; n < 2; ++n) {
                            const unsigned w0 = cvt_pk_bf16(acc[ai][bj][m][n][0], acc[ai][bj][m][n][1]), w1 = cvt_pk_bf16(acc[ai][bj][m][n][2], acc[ai][bj][m][n][3]);
                            bf16_t* dp = vp + (size_t)((bj * 2 + (wc >> 1)) * 64 + (wc & 1) * 32 + n * 16 + fq * 4) * stride;
                            dp[0] = (bf16_t)(w0 & 0xffff); dp[stride] = (bf16_t)(w0 >> 16); dp[2 * stride] = (bf16_t)(w1 & 0xffff); dp[3 * stride] = (bf16_t)(w1 >> 16);
                        }
                    asm volatile("" ::: "memory");
                }
        }
    }
};

template <class ColPtr>
__device__ __forceinline__ void conv_t(LAS float* tile, int K, int Nout, int lds, bf16_t* dst, int ldd, ColPtr colptr) {
    const int tilesK = K / 64, nt = tilesK * (Nout / 64);
    const int rr = threadIdx.x & 63, kk = threadIdx.x >> 6, r = threadIdx.x >> 3, kc = (threadIdx.x & 7) * 8;
    for (int t = blockIdx.x; t < nt; t += gridDim.x) {
        const int tk = t % tilesK, tn = t / tilesK;
        const float* sp = colptr(tn * 64 + rr) + (size_t)(tk * 64 + kk * 8) * lds;
        float v[8];
#pragma unroll
        for (int i = 0; i < 8; ++i) v[i] = sp[(size_t)i * lds];
#pragma unroll
        for (int i = 0; i < 8; ++i) tile[rr * 65 + kk * 8 + i] = v[i];
        __syncthreads();
        float o[8];
#pragma unroll
        for (int i = 0; i < 8; ++i) o[i] = tile[r * 65 + kc + i];
        u32x4 w; w.x = cvt_pk_bf16(o[0], o[1]); w.y = cvt_pk_bf16(o[2], o[3]); w.z = cvt_pk_bf16(o[4], o[5]); w.w = cvt_pk_bf16(o[6], o[7]);
        *(u32x4*)(dst + (size_t)(tn * 64 + r) * ldd + tk * 64 + kc) = w;
        __syncthreads();
    }
}

__device__ __forceinline__ void prologue_phase(const Params& p, LAS char* shm) {
    const int tid = threadIdx.x, wid = tid >> 6, lane = tid & 63;
    const int gtid = blockIdx.x * 512 + tid, gsz = gridDim.x * 512;
    if (gtid < 1024) {
        const int pos = gtid >> 4, i = gtid & 15;
        const float inv = exp2f(-(float)i * (13.287712379549449f / 16.0f));
        const float ang = (float)pos * inv;
        float* rt = (float*)(p.ws + OFF_ROPE);
        rt[gtid * 2] = __cosf(ang); rt[gtid * 2 + 1] = __sinf(ang);
    }
    if (gtid >= 1024 && gtid < 1024 + 2 * DM) { const int i = gtid - 1024; ((float*)(p.ws + OFF_SPW))[i] = -8.0f * log1pf(__expf(-p.rg_lambda[i])); }
    {
        LAS float* S = (LAS float*)shm;
        float* MOD = (float*)(p.ws + OFF_MOD);
        for (int it = blockIdx.x; it < 2 * 144; it += gridDim.x) {
            const int layer = it / 144, col0 = (it % 144) * 64;
            float acc[NCOND];
#pragma unroll
            for (int cn = 0; cn < NCOND; ++cn) acc[cn] = 0.f;
            for (int half = 0; half < 2; ++half) {
                __syncthreads();
                for (int idx = tid; idx < NCOND * 512; idx += 512) {
                    const int cn = idx >> 9, k = idx & 511;
                    const float v = cn < NB ? p.c[cn * DM + half * 512 + k] : p.c_ctx[half * 512 + k];
                    S[idx] = v / (1.0f + __expf(-v));
                }
                __syncthreads();
                const float* wp = p.w_mod + (size_t)layer * DM * (NMOD * DM) + (size_t)(half * 512 + wid * 64) * (NMOD * DM) + col0 + lane;
                for (int kb = 0; kb < 64; kb += 4) {
                    const float w0 = wp[(size_t)(kb + 0) * (NMOD * DM)], w1 = wp[(size_t)(kb + 1) * (NMOD * DM)], w2 = wp[(size_t)(kb + 2) * (NMOD * DM)], w3 = wp[(size_t)(kb + 3) * (NMOD * DM)];
#pragma unroll
                    for (int cn = 0; cn < NCOND; ++cn) {
                        const f32x4 s = *(const LAS f32x4*)(S + cn * 512 + wid * 64 + kb);
                        acc[cn] += (w0 * s[0] + w1 * s[1]) + (w2 * s[2] + w3 * s[3]);
                    }
                }
            }
            __syncthreads();
#pragma unroll
            for (int cn = 0; cn < NCOND; ++cn) S[(wid * NCOND + cn) * 64 + lane] = acc[cn];
            __syncthreads();
            for (int idx = tid; idx < NCOND * 64; idx += 512) {
                const int cn = idx >> 6, l = idx & 63;
                float s = p.b_mod[layer * (NMOD * DM) + col0 + l];
#pragma unroll
                for (int w = 0; w < 8; ++w) s += S[(w * NCOND + cn) * 64 + l];
                MOD[(size_t)(layer * NCOND + cn) * (NMOD * DM) + col0 + l] = s;
            }
        }
        __syncthreads();
    }
    LAS float* tile = (LAS float*)shm;
    for (int i = 0; i < 4; ++i) {
        const float* src = p.ffn_w_in + (size_t)i * DM * (2 * DFF);
        conv_t(tile, DM, 2 * DFF, 2 * DFF, (bf16_t*)(p.ws + OFF_W1 + i * SZ_W1), DM, [=](int r) {
            const int pn = r >> 8, q = r & 255;
            return src + (q >> 7) * DFF + pn * 128 + (q & 127); });
    }
    for (int i = 0; i < 4; ++i) {
        const float* src = p.ffn_w_out + (size_t)i * DFF * DM;
        conv_t(tile, DFF, DM, DM, (bf16_t*)(p.ws + OFF_W2 + i * SZ_W2), DFF, [=](int r) { return src + r; });
    }
    { const float* src = p.rg_w_in; conv_t(tile, DM, 2 * DM, 2 * DM, (bf16_t*)(p.ws + OFF_RGIN), DM, [=](int r) { return src + r; }); }
    { const float* src = p.rg_gate_w;
      conv_t(tile, 256, 4096, 256, (bf16_t*)(p.ws + OFF_WG), 256, [=](int r) {
          const int d = r >> 11, n = (r >> 9) & 3, half = (r >> 8) & 1, q = r & 255, g = q >> 7;
          return src + (size_t)(((d * 2 + g) * 4 + n) * 65536) + half * 128 + (q & 127); }); }
    for (int kh = 0; kh < 2; ++kh) { const float* src = p.rg_w_out; conv_t(tile, DM, DM, DM, (bf16_t*)(p.ws + OFF_RGOUT) + kh * DM, 2 * DM, [=](int r) { return src + r; }); }
    { const float* src = p.attn_w_qkv; conv_t(tile, DM, 1536, 1536, (bf16_t*)(p.ws + OFF_QKV), DM, [=](int r) { return src + r; }); }
    { const float* src = p.attn_w_o; conv_t(tile, DM, DM, DM, (bf16_t*)(p.ws + OFF_WO), DM, [=](int r) { return src + r; }); }
}

struct NMArgs {
    const float* hsrc_x; const float* hsrc_c; float* hdst_x; float* hdst_c;
    const bf16_t* Y; const float* ssq; const float* gate_mod; const float* gpost; float coef; int has_pending;
    const float* gpre; const float* shift_mod; const float* scale_mod; int has_next; bf16_t* Aout; int nrows;
};
__device__ __forceinline__ void nm_phase(const NMArgs& a) {
    const int lane = threadIdx.x & 63, wid = threadIdx.x >> 6;
    for (int row = blockIdx.x * 8 + wid; row < a.nrows; row += gridDim.x * 8) {
        const bool lat = row < XROWS;
        const int cn = lat ? (row >> 11) : NB;
        const float* hs = lat ? a.hsrc_x + (size_t)row * DM : a.hsrc_c + (size_t)(row - XROWS) * DM;
        f32x4 h[4];
#pragma unroll
        for (int ch = 0; ch < 4; ++ch) h[ch] = *(const f32x4*)(hs + ch * 256 + lane * 4);
        if (a.has_pending) {
            float sq;
            { const f32x4 q0 = *(const f32x4*)(a.ssq + (size_t)row * 16), q1 = *(const f32x4*)(a.ssq + (size_t)row * 16 + 4), q2 = *(const f32x4*)(a.ssq + (size_t)row * 16 + 8), q3 = *(const f32x4*)(a.ssq + (size_t)row * 16 + 12);
              const f32x4 qs = (q0 + q1) + (q2 + q3); sq = (qs[0] + qs[1]) + (qs[2] + qs[3]); }
            const float rstd = rsqrtf(sq * (1.0f / DM) + EPS) * a.coef;
            float* hd = lat ? a.hdst_x + (size_t)row * DM : a.hdst_c + (size_t)(row - XROWS) * DM;
#pragma unroll
            for (int ch = 0; ch < 4; ++ch) {
                const int e = ch * 256 + lane * 4;
                const u32x2 yw = *(const u32x2*)(a.Y + (size_t)row * DM + e);
                const f32x4 y = {bf_lo(yw.x), bf_hi(yw.x), bf_lo(yw.y), bf_hi(yw.y)};
                const f32x4 gm = *(const f32x4*)(a.gate_mod + (size_t)cn * (NMOD * DM) + e), gp = *(const f32x4*)(a.gpost + e);
                h[ch] += gm * ((y * rstd) * gp);
                *(f32x4*)(hd + e) = h[ch];
            }
        }
        if (a.has_next) {
            float ss = 0.f;
#pragma unroll
            for (int ch = 0; ch < 4; ++ch) ss += (h[ch][0] * h[ch][0] + h[ch][1] * h[ch][1]) + (h[ch][2] * h[ch][2] + h[ch][3] * h[ch][3]);
#pragma unroll
            for (int o = 32; o >= 1; o >>= 1) ss += __shfl_xor(ss, o);
            const float rstd = rsqrtf(ss * (1.0f / DM) + EPS);
#pragma unroll
            for (int ch = 0; ch < 4; ++ch) {
                const int e = ch * 256 + lane * 4;
                const f32x4 g = *(const f32x4*)(a.gpre + e), sh = *(const f32x4*)(a.shift_mod + (size_t)cn * (NMOD * DM) + e), sc = *(const f32x4*)(a.scale_mod + (size_t)cn * (NMOD * DM) + e);
                const f32x4 v = ((h[ch] * rstd) * g) * (1.0f + sc) + sh;
                u32x2 w; w.x = cvt_pk_bf16(v[0], v[1]); w.y = cvt_pk_bf16(v[2], v[3]);
                *(u32x2*)(a.Aout + (size_t)row * DM + e) = w;
            }
        }
    }
}

__device__ __forceinline__ void conv_phase(const bf16_t* XR, bf16_t* RX, const float* cw, const float* cb) {
    const int total = ROWS * 128;
    for (int i = blockIdx.x * 512 + threadIdx.x; i < total; i += gridDim.x * 512) {
        const int row = i >> 7, c0 = (i & 127) * 8;
        int t, len;
        if (row < XROWS) { t = row & 2047; len = SEQ; } else { t = (row - XROWS) & 255; len = CTX; }
        float acc[8];
        { const f32x4 b0 = *(const f32x4*)(cb + c0), b1 = *(const f32x4*)(cb + c0 + 4);
          acc[0] = b0[0]; acc[1] = b0[1]; acc[2] = b0[2]; acc[3] = b0[3]; acc[4] = b1[0]; acc[5] = b1[1]; acc[6] = b1[2]; acc[7] = b1[3]; }
#pragma unroll
        for (int k = 0; k < 4; ++k) {
            const int tt = t + k - 2;
            if (tt >= 0 && tt < len) {
                const u32x4 xw = *(const u32x4*)(XR + (size_t)(row + k - 2) * DM + c0);
                const f32x4 w0 = *(const f32x4*)(cw + k * DM + c0), w1 = *(const f32x4*)(cw + k * DM + c0 + 4);
                acc[0] += w0[0] * bf_lo(xw.x); acc[1] += w0[1] * bf_hi(xw.x); acc[2] += w0[2] * bf_lo(xw.y); acc[3] += w0[3] * bf_hi(xw.y);
                acc[4] += w1[0] * bf_lo(xw.z); acc[5] += w1[1] * bf_hi(xw.z); acc[6] += w1[2] * bf_lo(xw.w); acc[7] += w1[3] * bf_hi(xw.w);
            }
        }
        u32x4 w; w.x = cvt_pk_bf16(acc[0], acc[1]); w.y = cvt_pk_bf16(acc[2], acc[3]); w.z = cvt_pk_bf16(acc[4], acc[5]); w.w = cvt_pk_bf16(acc[6], acc[7]);
        *(u32x4*)(RX + (size_t)row * DM + c0) = w;
    }
}

__device__ __forceinline__ void scan_phase(const unsigned* AB, const bf16_t* GX, bf16_t* A2, int dir) {
    const int lane = threadIdx.x & 63, wid = threadIdx.x >> 6;
    const int it = wid * gridDim.x + blockIdx.x;
    if (it >= NB * 16) return;
    const int b = it >> 4, c = (it & 15) * 64 + lane;
    constexpr int U = 32, NBATCH = (CTX + SEQ) / U;
    float h = 0.f;
    unsigned abn[U]; bf16_t gxn[U];
    auto rowof = [&](int bt) -> int {
        const int s = bt * U;
        if (s < CTX) return XROWS + b * CTX + (dir ? (CTX - 1 - s) : s);
        return b * SEQ + (dir ? (SEQ - 1 - (s - CTX)) : (s - CTX));
    };
    const int stp = dir ? -1 : 1;
    { const int r0 = rowof(0);
#pragma unroll
      for (int i = 0; i < U; ++i) { const size_t o = (size_t)(r0 + stp * i) * DM + c; abn[i] = AB[o]; gxn[i] = GX[o]; } }
    for (int bt = 0; bt < NBATCH; ++bt) {
        unsigned abc[U]; bf16_t gxc[U];
#pragma unroll
        for (int i = 0; i < U; ++i) { abc[i] = abn[i]; gxc[i] = gxn[i]; }
        const int r0 = rowof(bt);
        if (bt + 1 < NBATCH) {
            const int r1 = rowof(bt + 1);
#pragma unroll
            for (int i = 0; i < U; ++i) { const size_t o = (size_t)(r1 + stp * i) * DM + c; abn[i] = AB[o]; gxn[i] = GX[o]; }
        }
#pragma unroll
        for (int i = 0; i < U; ++i) {
            const float a = __expf(bf_lo(abc[i])), bb = bf_hi(abc[i]);
            h = a * h + bb;
            const float o = __uint_as_float((unsigned)gxc[i] << 16) * h;
            A2[(size_t)(r0 + stp * i) * (2 * DM) + dir * DM + c] = (bf16_t)(cvt_pk_bf16(o, 0.f) & 0xffff);
        }
    }
}

__device__ __forceinline__ void attn_phase(const bf16_t* Q, const bf16_t* Kb, const bf16_t* Vt, const bf16_t* Vtc, const float* sink, bf16_t* O) {
    const int lane = threadIdx.x & 63, wid = threadIdx.x >> 6, fr = lane & 15, fq = lane >> 4;
    for (int it = blockIdx.x * 8 + wid; it < NB * 4 * 128; it += gridDim.x * 8) {
        const int qt = it & 127, kh = (it >> 7) & 3, b = it >> 9, q0 = qt * 16, qpos = q0 + fr;
        bf16x8 qf[4][2];
        { const bf16_t* qp = Q + (size_t)(b * SEQ + q0 + fr) * DM + kh * 256 + fq * 8;
#pragma unroll
          for (int g = 0; g < 4; ++g)
#pragma unroll
              for (int ks = 0; ks < 2; ++ks) qf[g][ks] = *(const bf16x8*)(qp + g * 64 + ks * 32); }
        float mrun[4], lrun[4]; f32x4 o[4][4];
#pragma unroll
        for (int g = 0; g < 4; ++g) { mrun[g] = sink[kh * 4 + g]; lrun[g] = 1.0f;
#pragma unroll
            for (int dt = 0; dt < 4; ++dt) o[g][dt] = (f32x4){0.f, 0.f, 0.f, 0.f}; }
        const int ks0 = (q0 & ~31) - 128;
        for (int bi = 0; bi < 17; ++bi) {
            const bool isctx = bi >= 9;
            int kbs, vstride; const bf16_t* kp; const bf16_t* vp;
            if (!isctx) {
                kbs = ks0 + bi * 32; if (kbs < 0 || kbs >= SEQ) continue;
                kp = Kb + (size_t)(b * SEQ + kbs + fr) * 256 + kh * 64 + fq * 8; vp = Vt + ((size_t)(b * 4 + kh) * 64 + fr) * SEQ + kbs + fq * 4; vstride = SEQ;
            } else {
                kbs = (bi - 9) * 32;
                kp = Kb + (size_t)(XROWS + b * CTX + kbs + fr) * 256 + kh * 64 + fq * 8; vp = Vtc + ((size_t)(b * 4 + kh) * 64 + fr) * CTX + kbs + fq * 4; vstride = CTX;
            }
            bf16x8 kf[2][2];
#pragma unroll
            for (int tl = 0; tl < 2; ++tl)
#pragma unroll
                for (int ks = 0; ks < 2; ++ks) kf[tl][ks] = *(const bf16x8*)(kp + tl * 16 * 256 + ks * 32);
            bf16x8 vf[4];
#pragma unroll
            for (int dt = 0; dt < 4; ++dt) {
                const u32x2 lo = *(const u32x2*)(vp + (size_t)dt * 16 * vstride), hi = *(const u32x2*)(vp + (size_t)dt * 16 * vstride + 16);
                u32x4 w; w.x = lo.x; w.y = lo.y; w.z = hi.x; w.w = hi.y;
                vf[dt] = __builtin_bit_cast(bf16x8, w);
            }
#pragma unroll
            for (int g = 0; g < 4; ++g) {
                f32x4 s0 = {0.f, 0.f, 0.f, 0.f}, s1 = {0.f, 0.f, 0.f, 0.f};
                s0 = __builtin_amdgcn_mfma_f32_16x16x32_bf16(kf[0][0], qf[g][0], s0, 0, 0, 0);
                s0 = __builtin_amdgcn_mfma_f32_16x16x32_bf16(kf[0][1], qf[g][1], s0, 0, 0, 0);
                s1 = __builtin_amdgcn_mfma_f32_16x16x32_bf16(kf[1][0], qf[g][0], s1, 0, 0, 0);
                s1 = __builtin_amdgcn_mfma_f32_16x16x32_bf16(kf[1][1], qf[g][1], s1, 0, 0, 0);
                if (!isctx) {
#pragma unroll
                    for (int j = 0; j < 4; ++j) {
                        const int d0 = kbs + fq * 4 + j - qpos, d1 = d0 + 16;
                        if (d0 > 128 || d0 < -128) s0[j] = -1e30f;
                        if (d1 > 128 || d1 < -128) s1[j] = -1e30f;
                    }
                }
                float mx = fmaxf(fmaxf(fmaxf(s0[0], s0[1]), fmaxf(s0[2], s0[3])), fmaxf(fmaxf(s1[0], s1[1]), fmaxf(s1[2], s1[3])));
                mx = fmaxf(mx, __shfl_xor(mx, 16)); mx = fmaxf(mx, __shfl_xor(mx, 32));
                const float mnew = fmaxf(mrun[g], mx), alpha = __expf(mrun[g] - mnew);
                mrun[g] = mnew;
                float p0[4], p1[4], ls = 0.f;
#pragma unroll
                for (int j = 0; j < 4; ++j) { p0[j] = __expf(s0[j] - mnew); p1[j] = __expf(s1[j] - mnew); ls += p0[j] + p1[j]; }
                ls += __shfl_xor(ls, 16); ls += __shfl_xor(ls, 32);
                lrun[g] = lrun[g] * alpha + ls;
                u32x4 pw; pw.x = cvt_pk_bf16(p0[0], p0[1]); pw.y = cvt_pk_bf16(p0[2], p0[3]); pw.z = cvt_pk_bf16(p1[0], p1[1]); pw.w = cvt_pk_bf16(p1[2], p1[3]);
                const bf16x8 pf = __builtin_bit_cast(bf16x8, pw);
#pragma unroll
                for (int dt = 0; dt < 4; ++dt) { o[g][dt] *= alpha; o[g][dt] = __builtin_amdgcn_mfma_f32_16x16x32_bf16(vf[dt], pf, o[g][dt], 0, 0, 0); }
            }
        }
#pragma unroll
        for (int g = 0; g < 4; ++g) {
            const float inv = 1.0f / lrun[g];
            bf16_t* op = O + (size_t)(b * SEQ + q0 + fr) * DM + (kh * 4 + g) * 64 + fq * 4;
#pragma unroll
            for (int dt = 0; dt < 4; ++dt) {
                const f32x4 v = o[g][dt] * inv;
                u32x2 w; w.x = cvt_pk_bf16(v[0], v[1]); w.y = cvt_pk_bf16(v[2], v[3]);
                *(u32x2*)(op + dt * 16) = w;
            }
        }
    }
}

constexpr int N_PHASES = 26;
enum { T_PRE, T_NM, T_W1, T_Y, T_RGIN, T_CONV, T_GATE, T_SCAN, T_QKV, T_ATTN };
struct PhaseDesc {
    int type = T_PRE;
    int nm_first = 0, nm_pl = 0, nm_pidx = 0, nm_pg = 0, nm_ssq = 0, nm_py3 = 0, nm_nl = 0, nm_nidx = 0, nm_ng = 0, nm_next = 1, nm_rows = ROWS; float nm_coef = 0.5f;
    int w_idx = 0, nM = ROWS / 256, ssq_i = 0, dir = 0, ykind = 0;
};
constexpr PhaseDesc phase_desc(int ph) {
    PhaseDesc d;
    switch (ph) {
        case 0: d.type = T_PRE; break;
        case 1: d.type = T_NM; d.nm_first = 1; d.nm_nl = 0; d.nm_nidx = 0; d.nm_ng = 0; break;
        case 2: d.type = T_W1; d.w_idx = 0; break;
        case 3: d.type = T_Y; d.ykind = 0; d.w_idx = 0; d.ssq_i = 0; break;
        case 4: d.type = T_NM; d.nm_pl = 0; d.nm_pidx = 2; d.nm_pg = 3; d.nm_ssq = 0; d.nm_nl = 0; d.nm_nidx = 3; d.nm_ng = 1; break;
        case 5: d.type = T_RGIN; break;
        case 6: d.type = T_CONV; break;
        case 7: d.type = T_GATE; d.dir = 0; break;
        case 8: d.type = T_SCAN; d.dir = 0; break;
        case 9: d.type = T_GATE; d.dir = 1; break;
        case 10: d.type = T_SCAN; d.dir = 1; break;
        case 11: d.type = T_Y; d.ykind = 1; d.ssq_i = 1; break;
        case 12: d.type = T_NM; d.nm_pl = 0; d.nm_pidx = 5; d.nm_pg = 4; d.nm_ssq = 1; d.nm_py3 = 1; d.nm_coef = 1.0f; d.nm_nl = 0; d.nm_nidx = 6; d.nm_ng = 2; break;
        case 13: d.type = T_W1; d.w_idx = 1; break;
        case 14: d.type = T_Y; d.ykind = 0; d.w_idx = 1; d.ssq_i = 2; break;
        case 15: d.type = T_NM; d.nm_pl = 0; d.nm_pidx = 8; d.nm_pg = 5; d.nm_ssq = 2; d.nm_nl = 1; d.nm_nidx = 0; d.nm_ng = 0; break;
        case 16: d.type = T_W1; d.w_idx = 2; break;
        case 17: d.type = T_Y; d.ykind = 0; d.w_idx = 2; d.ssq_i = 3; break;
        case 18: d.type = T_NM; d.nm_pl = 1; d.nm_pidx = 2; d.nm_pg = 3; d.nm_ssq = 3; d.nm_nl = 1; d.nm_nidx = 3; d.nm_ng = 1; break;
        case 19: d.type = T_QKV; break;
        case 20: d.type = T_ATTN; break;
        case 21: d.type = T_Y; d.ykind = 2; d.ssq_i = 4; d.nM = XROWS / 256; break;
        case 22: d.type = T_NM; d.nm_pl = 1; d.nm_pidx = 5; d.nm_pg = 4; d.nm_ssq = 4; d.nm_py3 = 1; d.nm_coef = 1.0f; d.nm_nl = 1; d.nm_nidx = 6; d.nm_ng = 2; d.nm_rows = XROWS; break;
        case 23: d.type = T_W1; d.w_idx = 3; d.nM = XROWS / 256; break;
        case 24: d.type = T_Y; d.ykind = 0; d.w_idx = 3; d.ssq_i = 5; d.nM = XROWS / 256; break;
        default: d.type = T_NM; d.nm_pl = 1; d.nm_pidx = 8; d.nm_pg = 5; d.nm_ssq = 5; d.nm_next = 0; d.nm_rows = XROWS; break;
    }
    return d;
}

#ifndef TMASK
#define TMASK 0x3ff
#endif
template <int PH>
__device__ __forceinline__ void run_phase(const Params& p, LAS char* shm) {
    constexpr PhaseDesc d = phase_desc(PH);
    if constexpr (((TMASK >> d.type) & 1) != 0) {
    char* ws = p.ws;
    bf16_t* R0 = (bf16_t*)(ws + OFF_R0); bf16_t* R1 = (bf16_t*)(ws + OFF_R1); bf16_t* R2 = (bf16_t*)(ws + OFF_R2); bf16_t* R3 = (bf16_t*)(ws + OFF_R3); bf16_t* R4 = (bf16_t*)(ws + OFF_R4);
    float* MOD = (float*)(ws + OFF_MOD); float* SSQ = (float*)(ws + OFF_SSQ); float* HC = (float*)(ws + OFF_HC);
    if constexpr (d.type == T_PRE) prologue_phase(p, shm);
    else if constexpr (d.type == T_NM) {
        NMArgs a;
        a.hsrc_x = (PH <= 4) ? p.x : p.out; a.hsrc_c = (PH <= 4) ? p.ctx : HC; a.hdst_x = p.out; a.hdst_c = HC;
        a.Y = d.nm_py3 ? R3 : R1; a.ssq = SSQ;
        a.gate_mod = MOD + (size_t)d.nm_pl * NCOND * (NMOD * DM) + d.nm_pidx * DM; a.gpost = p.norm_g + (d.nm_pl * 6 + d.nm_pg) * DM; a.coef = d.nm_coef; a.has_pending = !d.nm_first;
        a.gpre = p.norm_g + (d.nm_nl * 6 + d.nm_ng) * DM; a.shift_mod = MOD + (size_t)d.nm_nl * NCOND * (NMOD * DM) + d.nm_nidx * DM; a.scale_mod = a.shift_mod + DM;
        a.has_next = d.nm_next; a.Aout = R0; a.nrows = d.nm_rows;
        nm_phase(a);
    } else if constexpr (d.type == T_W1) { EpiSwiglu e{R2}; gemm_phase<false>(shm, R0, DM, (const bf16_t*)(ws + OFF_W1 + d.w_idx * SZ_W1), DM, d.nM, 22, DM, e); }
    else if constexpr (d.type == T_Y) {
        if constexpr (d.ykind == 0) { EpiY e{R1, SSQ}; gemm_phase<false>(shm, R2, DFF, (const bf16_t*)(ws + OFF_W2 + d.w_idx * SZ_W2), DFF, d.nM, 4, DFF, e); }
        else if constexpr (d.ykind == 1) { EpiY e{R3, SSQ}; gemm_phase<false>(shm, R0, 2 * DM, (const bf16_t*)(ws + OFF_RGOUT), 2 * DM, d.nM, 4, 2 * DM, e); }
        else { EpiY e{R3, SSQ}; gemm_phase<false>(shm, R1, DM, (const bf16_t*)(ws + OFF_WO), DM, d.nM, 4, DM, e); }
    } else if constexpr (d.type == T_RGIN) { EpiRgIn e{R2, R1}; gemm_phase<false>(shm, R0, DM, (const bf16_t*)(ws + OFF_RGIN), DM, ROWS / 256, 8, DM, e); }
    else if constexpr (d.type == T_CONV) conv_phase(R1, R3, p.rg_conv_w, p.rg_conv_b);
    else if constexpr (d.type == T_GATE) {
        EpiGate e{R3, (unsigned*)R4, p.rg_gate_b + (d.dir * 2 + 0) * DM, p.rg_gate_b + (d.dir * 2 + 1) * DM, (const float*)(ws + OFF_SPW) + d.dir * DM};
        gemm_phase<true>(shm, R3, DM, (const bf16_t*)(ws + OFF_WG) + (size_t)d.dir * 8 * 65536, 256, ROWS / 256, 8, 256, e);
    } else if constexpr (d.type == T_SCAN) scan_phase((const unsigned*)R4, R2, R0, d.dir);
    else if constexpr (d.type == T_QKV) {
        EpiQkv e{R2, R4, (bf16_t*)(ws + OFF_R4 + 40 * MiB), (bf16_t*)(ws + OFF_R4 + 80 * MiB), (const float*)(ws + OFF_ROPE)};
        gemm_phase<false>(shm, R0, DM, (const bf16_t*)(ws + OFF_QKV), DM, ROWS / 256, 6, DM, e);
    } else if constexpr (d.type == T_ATTN) attn_phase(R2, R4, (const bf16_t*)(ws + OFF_R4 + 40 * MiB), (const bf16_t*)(ws + OFF_R4 + 80 * MiB), p.attn_sink, R1);
    }
}

template <int PH>
__device__ __forceinline__ void do_phase(const Params& p, LAS char* shm, cg::grid_group& grid) {
    if (PH >= (int)p.ph_lo && PH < (int)p.ph_hi) {
        if (PH > (int)p.ph_lo) grid.sync();
        run_phase<PH>(p, shm);
    }
}

__global__ void __launch_bounds__(512) fwd_megakernel(Params p) {
    __shared__ __attribute__((aligned(1024))) char shm_[STAGE_BYTES];
    LAS char* shm = (LAS char*)shm_;
    cg::grid_group grid = cg::this_grid();
    do_phase<0>(p, shm, grid); do_phase<1>(p, shm, grid); do_phase<2>(p, shm, grid); do_phase<3>(p, shm, grid); do_phase<4>(p, shm, grid);
    do_phase<5>(p, shm, grid); do_phase<6>(p, shm, grid); do_phase<7>(p, shm, grid); do_phase<8>(p, shm, grid); do_phase<9>(p, shm, grid);
    do_phase<10>(p, shm, grid); do_phase<11>(p, shm, grid); do_phase<12>(p, shm, grid); do_phase<13>(p, shm, grid); do_phase<14>(p, shm, grid);
    do_phase<15>(p, shm, grid); do_phase<16>(p, shm, grid); do_phase<17>(p, shm, grid); do_phase<18>(p, shm, grid); do_phase<19>(p, shm, grid);
    do_phase<20>(p, shm, grid); do_phase<21>(p, shm, grid); do_phase<22>(p, shm, grid); do_phase<23>(p, shm, grid); do_phase<24>(p, shm, grid);
    do_phase<25>(p, shm, grid);
}

extern "C" void kernel_launch(void* const* d_in, const int* in_sizes, int n_in, void* d_out, int out_size, void* d_ws, size_t ws_size, hipStream_t stream) {
    static int grid_blocks = 0;
    if (!grid_blocks) {
        int dev = 0, cus = 0, per_cu = 0;
        hipGetDevice(&dev);
        hipDeviceGetAttribute(&cus, hipDeviceAttributeMultiprocessorCount, dev);
        hipOccupancyMaxActiveBlocksPerMultiprocessor(&per_cu, fwd_megakernel, 512, 0);
        if (per_cu < 1) per_cu = 1;
        if (per_cu > 1) per_cu = 1;
        grid_blocks = cus * per_cu;
        if (grid_blocks % 8) grid_blocks -= grid_blocks % 8;
        if (ws_size < WS_END || n_in != 19) { fprintf(stderr, "kernel_launch: unexpected workspace %zu (< %zu) or n_in %d\n", ws_size, (size_t)WS_END, n_in); }
    }
    Params p{};
    const float** pp = (const float**)&p;
    for (int i = 0; i < 19; ++i) pp[i] = (const float*)d_in[i];
    p.out = (float*)d_out; p.ws = (char*)d_ws;
#if MK_MULTI
    for (int ph = 0; ph < N_PHASES; ++ph) {
        p.ph_lo = ph; p.ph_hi = ph + 1;
        hipLaunchKernelGGL(fwd_megakernel, dim3(grid_blocks), dim3(512), 0, stream, p);
    }
#else
    p.ph_lo = 0; p.ph_hi = N_PHASES;
    void* args[] = {&p};
    hipError_t e = hipLaunchCooperativeKernel((void*)fwd_megakernel, dim3(grid_blocks), dim3(512), args, 0, stream);
    if (e != hipSuccess) fprintf(stderr, "cooperative launch failed: %s (grid %d)\n", hipGetErrorString(e), grid_blocks);
#endif
}
```

```cpp
#include <hip/hip_runtime.h>
#include <hip/hip_cooperative_groups.h>
#include <cstdio>
#include <cstdint>
namespace cg = cooperative_groups;

#ifndef MK_MULTI
#define MK_MULTI 0
#endif

typedef unsigned short bf16_t;
typedef short bf16x8 __attribute__((ext_vector_type(8)));
typedef float f32x4 __attribute__((ext_vector_type(4)));
typedef float f32x2 __attribute__((ext_vector_type(2)));
typedef unsigned u32x2 __attribute__((ext_vector_type(2)));
typedef unsigned u32x4 __attribute__((ext_vector_type(4)));
#define LAS __attribute__((address_space(3)))

constexpr int DM = 1024, NB = 32, SEQ = 2048, CTX = 256, DFF = 2816, NMOD = 9;
constexpr int XROWS = NB * SEQ;
constexpr int CROWS = NB * CTX;
constexpr int ROWS = XROWS + CROWS;
constexpr int NCOND = NB + 1;
constexpr float EPS = 1e-6f;

constexpr size_t MiB = 1u << 20;
constexpr size_t OFF_W1 = 0;
constexpr size_t SZ_W1 = (size_t)5632 * 1024 * 2;
constexpr size_t OFF_W2 = 44 * MiB;
constexpr size_t SZ_W2 = (size_t)1024 * 2816 * 2;
constexpr size_t OFF_RGIN = 66 * MiB;
constexpr size_t OFF_WG = 70 * MiB;
constexpr size_t OFF_RGOUT = 72 * MiB;
constexpr size_t OFF_QKV = 76 * MiB;
constexpr size_t OFF_WO = 79 * MiB;
constexpr size_t OFF_MOD = 81 * MiB;
constexpr size_t OFF_SSQ = 984 * MiB;
constexpr size_t OFF_ROPE = 86 * MiB;
constexpr size_t OFF_SPW = 86 * MiB + 65536;
constexpr size_t OFF_BAR = 86 * MiB + 262144;
constexpr size_t OFF_HC = 87 * MiB;
constexpr size_t OFF_R0 = 119 * MiB;
constexpr size_t SZ_R = 144 * MiB;
constexpr size_t OFF_R1 = OFF_R0 + SZ_R, OFF_R2 = OFF_R1 + SZ_R, OFF_R3 = OFF_R2 + SZ_R, OFF_R4 = OFF_R3 + SZ_R;
constexpr size_t WS_END = 989 * MiB;

struct Params {
    const float *x, *c, *ctx, *c_ctx, *w_mod, *b_mod, *norm_g, *ffn_w_in, *ffn_w_out, *rg_w_in, *rg_conv_w, *rg_conv_b, *rg_gate_w, *rg_gate_b,
        *rg_lambda, *rg_w_out, *attn_w_qkv, *attn_w_o, *attn_sink;
    float* out;
    char* ws;
    long long ph_lo, ph_hi;
};

__device__ __forceinline__ unsigned cvt_pk_bf16(float lo, float hi) { unsigned r; asm("v_cvt_pk_bf16_f32 %0, %1, %2" : "=v"(r) : "v"(lo), "v"(hi)); return r; }
__device__ __forceinline__ float bf_lo(unsigned w) { return __uint_as_float(w << 16); }
__device__ __forceinline__ float bf_hi(unsigned w) { return __uint_as_float(w & 0xffff0000u); }
__device__ __forceinline__ float sigmoidf_(float v) { return __builtin_amdgcn_rcpf(1.0f + __expf(-v)); }

constexpr int HTB = 128 * 64 * 2, STAGE_BYTES = 8 * HTB;
__device__ __forceinline__ int lds_byte(int r, int c) { const int st = (r >> 4) * 2 + (c >> 5), rr = r & 15, cc = c & 31, ob = rr * 64 + cc * 2; return st * 1024 + (ob ^ (((ob >> 9) & 1) << 5)); }
__device__ __forceinline__ void stage_rc(int b, int& R, int& C) { const int st = b / 1024, sb = b % 1024, swz = sb ^ (((sb >> 9) & 1) << 5); R = (st >> 1) * 16 + swz / 64; C = (st & 1) * 32 + (swz % 64) / 2; }
struct Unit { int pm, pn; };
struct StaticOrder {
    int nM, nN, nwg, G, c;
    __device__ __forceinline__ void init(int nM_, int nN_, int G_, int c_) { nM = nM_; nN = nN_; nwg = nM * nN; G = G_; c = c_; }
    __device__ __forceinline__ bool next(int i, Unit& u) const {
        const long L = (long)i * G + c; if (L >= nwg) return false;
        int wgid = (int)L; { const int q = nwg / 8, r = nwg % 8, xcd = wgid % 8, off = wgid / 8; wgid = (xcd < r ? xcd * (q + 1) : r * (q + 1) + (xcd - r) * q) + off; }
        const int nig = 8 * nN, gid = wgid / nig, fm = gid * 8, gsz = (nM - fm) < 8 ? (nM - fm) : 8;
        u.pm = fm + ((wgid % nig) % gsz); u.pn = (wgid % nig) / gsz; return true;
    }
};

template <bool GATE, class Epi>
__device__ __forceinline__ void gemm_phase(LAS char* lds, const bf16_t* A, int lda, const bf16_t* Bt, int ldb, int nM, int nN, int K, const Epi& E) {
    const int tid = threadIdx.x, wid = __builtin_amdgcn_readfirstlane(tid >> 6), lane = tid & 63, wr = wid >> 2, wc = wid & 3, fr = lane & 15, fq = lane >> 4;
    const int nt = K / 64;
    StaticOrder S; S.init(nM, nN, gridDim.x, blockIdx.x);
    unsigned voffA[2], voffB[2];
#pragma unroll
    for (int i = 0; i < 2; ++i) { int R, C; stage_rc(tid * 16 + i * 8192, R, C); voffA[i] = (unsigned)(R * lda + C) * 2u; voffB[i] = (unsigned)(R * ldb + C) * 2u; }
    const size_t kstep = 128;
    const size_t hstepA = (size_t)128 * lda * 2, hstepB = (size_t)128 * ldb * 2;
    const size_t tstepA = 2 * hstepA, tstepB = 2 * hstepB;
    const unsigned ldsw = (unsigned)wid * 1024u;
    LAS char* ldsA = lds + lds_byte(wr * 64 + fr, fq * 8);
    LAS char* ldsB = lds + 4 * HTB + lds_byte(wc * 32 + fr, fq * 8);
    asm volatile("" : "+v"(ldsA), "+v"(ldsB));
#define PG8_SA(b, h) (((b) * 2 + (h)) * HTB)
#define PG8_SB(b, h) ((4 + (b) * 2 + (h)) * HTB)
#define PG8_STAGE(bufoff, gbase, voff) do { _Pragma("unroll") for (int _i = 0; _i < 2; ++_i) \
        __builtin_amdgcn_global_load_lds((const unsigned*)((const char*)(gbase) + (voff)[_i]), (LAS unsigned*)(lds + (bufoff) + ldsw + _i * 8192), 16, 0, 0); } while (0)
#define PG8_LDA(dst, b, h) do { _Pragma("unroll") for (int m = 0; m < 4; ++m) _Pragma("unroll") for (int k = 0; k < 2; ++k) dst[m][k] = *(const LAS bf16x8*)(ldsA + PG8_SA(b, h) + m * 2048 + k * 1024); } while (0)
#define PG8_LDB(dst, b, h) do { _Pragma("unroll") for (int n = 0; n < 2; ++n) _Pragma("unroll") for (int k = 0; k < 2; ++k) dst[n][k] = *(const LAS bf16x8*)(ldsB + ((b) * 2 + (h)) * HTB + n * 2048 + k * 1024); } while (0)
#define PG8_MMA(ai, bj, At, Bt_) do { __builtin_amdgcn_s_setprio(1); _Pragma("unroll") for (int m = 0; m < 4; ++m) _Pragma("unroll") for (int n = 0; n < 2; ++n) _Pragma("unroll") for (int k = 0; k < 2; ++k) \
        acc[ai][bj][m][n] = __builtin_amdgcn_mfma_f32_16x16x32_bf16(Bt_[n][k], At[m][k], acc[ai][bj][m][n], 0, 0, 0); __builtin_amdgcn_s_setprio(0); } while (0)
#define PG8_WAIT_V(n) asm volatile("s_waitcnt vmcnt(" #n ")" ::: "memory")
#define PG8_WAIT_L(n) asm volatile("s_waitcnt lgkmcnt(" #n ")" ::: "memory")
#define PG8_BAR __builtin_amdgcn_s_barrier()
#define PG8_SCHED __builtin_amdgcn_sched_barrier(0)
#define PG8_ABASE(u) ((const char*)A + (size_t)(u).pm * tstepA + (GATE ? (size_t)((u).pn >> 1) * 512 : 0))
#define PG8_BBASE(u) ((const char*)Bt + (size_t)(u).pn * tstepB)
    Unit cur, nxt; int ui = 0;
    if (!S.next(0, cur)) return;
    f32x4 acc[2][2][4][2];
#pragma unroll
    for (int a = 0; a < 2; ++a)
#pragma unroll
        for (int b = 0; b < 2; ++b)
#pragma unroll
            for (int m = 0; m < 4; ++m)
#pragma unroll
                for (int n = 0; n < 2; ++n) acc[a][b][m][n] = (f32x4){0.f, 0.f, 0.f, 0.f};
    bf16x8 At[4][2], B0[2][2], B1[2][2];
    const char* cA = PG8_ABASE(cur); const char* cB = PG8_BBASE(cur);
    PG8_STAGE(PG8_SB(0, 0), cB, voffB); PG8_STAGE(PG8_SB(0, 1), cB + hstepB, voffB); PG8_STAGE(PG8_SA(0, 0), cA, voffA); PG8_STAGE(PG8_SA(0, 1), cA + hstepA, voffA);
    if (wr == 1) PG8_BAR;
    PG8_WAIT_V(2); PG8_BAR;
    PG8_STAGE(PG8_SB(1, 0), cB + kstep, voffB); PG8_STAGE(PG8_SA(1, 0), cA + kstep, voffA); PG8_STAGE(PG8_SB(1, 1), cB + hstepB + kstep, voffB);
    PG8_WAIT_V(6); PG8_BAR;
    for (;;) {
        const bool has_next = S.next(ui + 1, nxt);
        const char* nA = has_next ? PG8_ABASE(nxt) : cA; const char* nB = has_next ? PG8_BBASE(nxt) : cB;
        for (int t = 0; t < nt; t += 2) {
            const bool last = (t == nt - 2);
            const char* a1 = cA + (size_t)(t + 1) * kstep;
            const char* a2 = last ? nA : cA + (size_t)(t + 2) * kstep; const char* b2 = last ? nB : cB + (size_t)(t + 2) * kstep;
            const char* a3 = a2 + kstep; const char* b3 = b2 + kstep;
            PG8_LDB(B0, 0, 0); PG8_LDB(B1, 0, 1); PG8_SCHED; PG8_LDA(At, 0, 0); PG8_STAGE(PG8_SA(1, 1), a1 + hstepA, voffA);
            PG8_WAIT_V(8); PG8_WAIT_L(0); PG8_BAR; PG8_MMA(0, 0, At, B0); PG8_MMA(0, 1, At, B1); PG8_BAR; PG8_SCHED;
            PG8_LDA(At, 0, 1); PG8_STAGE(PG8_SB(0, 0), b2, voffB); PG8_STAGE(PG8_SB(0, 1), b2 + hstepB, voffB); PG8_STAGE(PG8_SA(0, 0), a2, voffA);
            PG8_WAIT_V(8); PG8_WAIT_L(0); PG8_BAR; PG8_MMA(1, 0, At, B0); PG8_MMA(1, 1, At, B1); PG8_BAR; PG8_SCHED;
            PG8_LDB(B0, 1, 0); PG8_LDB(B1, 1, 1); PG8_SCHED; PG8_LDA(At, 1, 0); PG8_STAGE(PG8_SA(0, 1), a2 + hstepA, voffA);
            PG8_WAIT_V(8); PG8_WAIT_L(0); PG8_BAR; PG8_MMA(0, 0, At, B0); PG8_MMA(0, 1, At, B1); PG8_BAR; PG8_SCHED;
            PG8_LDA(At, 1, 1); PG8_STAGE(PG8_SB(1, 0), b3, voffB); PG8_STAGE(PG8_SB(1, 1), b3 + hstepB, voffB); PG8_STAGE(PG8_SA(1, 0), a3, voffA);
            PG8_WAIT_V(8); PG8_WAIT_L(0); PG8_BAR; PG8_MMA(1, 0, At, B0); PG8_MMA(1, 1, At, B1); PG8_BAR; PG8_SCHED;
        }
        if (wr == 0) PG8_BAR;
        E(acc, cur, wr, wc, fr, fq);
        if (!has_next) break;
#pragma unroll
        for (int a = 0; a < 2; ++a)
#pragma unroll
            for (int b = 0; b < 2; ++b)
#pragma unroll
                for (int m = 0; m < 4; ++m)
#pragma unroll
                    for (int n = 0; n < 2; ++n) acc[a][b][m][n] = (f32x4){0.f, 0.f, 0.f, 0.f};
        cur = nxt; cA = nA; cB = nB; ++ui;
        if (wr == 1) PG8_BAR;
    }
    PG8_WAIT_V(0);
    PG8_BAR;
#undef PG8_SA
#undef PG8_SB
#undef PG8_STAGE
#undef PG8_LDA
#undef PG8_LDB
#undef PG8_MMA
#undef PG8_WAIT_V
#undef PG8_WAIT_L
#undef PG8_BAR
#undef PG8_SCHED
#undef PG8_ABASE
#undef PG8_BBASE
}

typedef f32x4 Acc[2][2][4][2];
struct EpiSwiglu {
    bf16_t* H;
    __device__ __forceinline__ void operator()(Acc& acc, const Unit& u, int wr, int wc, int fr, int fq) const {
        const unsigned o0 = (unsigned)(u.pm * 256 + wr * 64 + fr) * DFF + u.pn * 128 + wc * 32 + fq * 4;
#pragma unroll
        for (int ai = 0; ai < 2; ++ai)
#pragma unroll
            for (int m = 0; m < 4; ++m) {
#pragma unroll
                for (int n = 0; n < 2; ++n) {
                    const f32x4 g = acc[ai][0][m][n], up = acc[ai][1][m][n];
                    f32x4 v;
#pragma unroll
                    for (int j = 0; j < 4; ++j) v[j] = g[j] * sigmoidf_(g[j]) * up[j];
                    u32x2 w; w.x = cvt_pk_bf16(v[0], v[1]); w.y = cvt_pk_bf16(v[2], v[3]);
                    *(u32x2*)(H + (o0 + (unsigned)((ai * 128 + m * 16) * DFF + n * 16))) = w;
                }
                asm volatile("" ::: "memory");
            }
    }
};
struct EpiY {
    bf16_t* Y; float* ssq;
    __device__ __forceinline__ void operator()(Acc& acc, const Unit& u, int wr, int wc, int fr, int fq) const {
        const unsigned r0 = (unsigned)(u.pm * 256 + wr * 64 + fr);
        const unsigned o0 = r0 * DM + u.pn * 256 + wc * 32 + fq * 4;
#pragma unroll
        for (int ai = 0; ai < 2; ++ai)
#pragma unroll
            for (int m = 0; m < 4; ++m) {
                float s = 0.f;
#pragma unroll
                for (int bj = 0; bj < 2; ++bj)
#pragma unroll
                    for (int n = 0; n < 2; ++n) {
                        const f32x4 v = acc[ai][bj][m][n];
                        s += (v[0] * v[0] + v[1] * v[1]) + (v[2] * v[2] + v[3] * v[3]);
                        u32x2 w; w.x = cvt_pk_bf16(v[0], v[1]); w.y = cvt_pk_bf16(v[2], v[3]);
                        *(u32x2*)(Y + (o0 + (unsigned)((ai * 128 + m * 16) * DM + bj * 128 + n * 16))) = w;
                    }
                s += __shfl_xor(s, 16); s += __shfl_xor(s, 32);
                if (fq == 0) ssq[(r0 + (unsigned)(ai * 128 + m * 16)) * 16 + u.pn * 4 + wc] = s;
                asm volatile("" ::: "memory");
            }
    }
};
struct EpiRgIn {
    bf16_t* GX; bf16_t* XR;
    __device__ __forceinline__ void operator()(Acc& acc, const Unit& u, int wr, int wc, int fr, int fq) const {
        const bool isg = u.pn < 4;
        bf16_t* base = isg ? GX : XR;
        const unsigned o0 = (unsigned)(u.pm * 256 + wr * 64 + fr) * DM + (u.pn & 3) * 256 + wc * 32 + fq * 4;
#pragma unroll
        for (int ai = 0; ai < 2; ++ai)
#pragma unroll
            for (int m = 0; m < 4; ++m) {
#pragma unroll
                for (int bj = 0; bj < 2; ++bj)
#pragma unroll
                    for (int n = 0; n < 2; ++n) {
                        f32x4 v = acc[ai][bj][m][n];
                        if (isg) {
#pragma unroll
                            for (int j = 0; j < 4; ++j) { const float t = v[j], u2 = 1.5957691216f * (t + 0.044715f * t * t * t); v[j] = t * sigmoidf_(u2); }
                        }
                        u32x2 w; w.x = cvt_pk_bf16(v[0], v[1]); w.y = cvt_pk_bf16(v[2], v[3]);
                        *(u32x2*)(base + (o0 + (unsigned)((ai * 128 + m * 16) * DM + bj * 128 + n * 16))) = w;
                    }
                asm volatile("" ::: "memory");
            }
    }
};
struct EpiGate {
    const bf16_t* RX; unsigned* AB; const float* gb_r; const float* gb_i; const float* spw;
    __device__ __forceinline__ void operator()(Acc& acc, const Unit& u, int wr, int wc, int fr, int fq) const {
        const int cb = (u.pn >> 1) * 256 + (u.pn & 1) * 128 + wc * 32 + fq * 4;
        const unsigned o0 = (unsigned)(u.pm * 256 + wr * 64 + fr) * DM + cb;
#pragma unroll
        for (int ai = 0; ai < 2; ++ai)
#pragma unroll
            for (int m = 0; m < 4; ++m) {
#pragma unroll
                for (int n = 0; n < 2; ++n) {
                    const unsigned ro = o0 + (unsigned)((ai * 128 + m * 16) * DM + n * 16);
                    const f32x4 brn = *(const f32x4*)(gb_r + cb + n * 16), bin = *(const f32x4*)(gb_i + cb + n * 16), spn = *(const f32x4*)(spw + cb + n * 16);
                    const u32x2 xw = *(const u32x2*)(RX + ro);
                    const float xv[4] = {bf_lo(xw.x), bf_hi(xw.x), bf_lo(xw.y), bf_hi(xw.y)};
                    u32x4 o;
#pragma unroll
                    for (int j = 0; j < 4; ++j) {
                        const float r = sigmoidf_(acc[ai][0][m][n][j] + brn[j]), ig = sigmoidf_(acc[ai][1][m][n][j] + bin[j]);
                        const float la = spn[j] * r, x2 = 2.0f * la;
                        const float om = x2 > -0.1f ? -x2 * (1.0f + x2 * (0.5f + x2 * (0.16666667f + x2 * 0.041666667f))) : 1.0f - __expf(x2);
                        const float mult = __builtin_amdgcn_sqrtf(fmaxf(om, 0.f));
                        o[j] = cvt_pk_bf16(la, mult * ig * xv[j]);
                    }
                    *(u32x4*)(AB + ro) = o;
                    asm volatile("" ::: "memory");
                }
            }
    }
};
struct EpiQkv {
    bf16_t* Q; bf16_t* Kb; bf16_t* Vt; bf16_t* Vtc; const float* rope;
    __device__ __forceinline__ void operator()(Acc& acc, const Unit& u, int wr, int wc, int fr, int fq) const {
        const bool latent = u.pm < 256;
        const int pn = u.pn;
        if (pn < 5) {
            if (pn < 4 && !latent) return;
            const float sc = pn < 4 ? 0.125f * 1.4426950408889634f : 1.0f;
#pragma unroll
            for (int ai = 0; ai < 2; ++ai)
#pragma unroll
                for (int m = 0; m < 4; ++m) {
                    const int row = u.pm * 256 + ai * 128 + wr * 64 + m * 16 + fr;
                    float rc[4] = {1.f, 1.f, 1.f, 1.f}, rs[4] = {0.f, 0.f, 0.f, 0.f};
                    if (latent) {
                        const int t = row & 2047, pos = (wc & 1) ? (t & 63) : (t >> 6);
                        const f32x4 ra = *(const f32x4*)(rope + (pos * 16 + fq * 4) * 2), rb = *(const f32x4*)(rope + (pos * 16 + fq * 4) * 2 + 4);
                        rc[0] = ra[0]; rc[1] = ra[2]; rc[2] = rb[0]; rc[3] = rb[2]; rs[0] = ra[1]; rs[1] = ra[3]; rs[2] = rb[1]; rs[3] = rb[3];
                    }
                    bf16_t* rp = (pn < 4) ? Q + (size_t)row * 1024 + pn * 256 + wc * 32 + fq * 4 : Kb + (size_t)row * 256 + wc * 32 + fq * 4;
#pragma unroll
                    for (int bj = 0; bj < 2; ++bj) {
                        f32x4 v0 = acc[ai][bj][m][0], v1 = acc[ai][bj][m][1];
#pragma unroll
                        for (int j = 0; j < 4; ++j) { const float a1 = v0[j], a2 = v1[j]; v0[j] = (a1 * rc[j] - a2 * rs[j]) * sc; v1[j] = (a2 * rc[j] + a1 * rs[j]) * sc; }
                        u32x2 w;
                        w.x = cvt_pk_bf16(v0[0], v0[1]); w.y = cvt_pk_bf16(v0[2], v0[3]); *(u32x2*)(rp + bj * 128) = w;
                        w.x = cvt_pk_bf16(v1[0], v1[1]); w.y = cvt_pk_bf16(v1[2], v1[3]); *(u32x2*)(rp + bj * 128 + 16) = w;
                    }
                    asm volatile("" ::: "memory");
                }
        } else {
#pragma unroll
            for (int ai = 0; ai < 2; ++ai)
#pragma unroll
                for (int m = 0; m < 4; ++m) {
                    const int row = u.pm * 256 + ai * 128 + wr * 64 + m * 16 + fr;
                    bf16_t* vp; int stride;
                    if (latent) { const int b = row >> 11, t = row & 2047; vp = Vt + (size_t)(b * 4) * 64 * 2048 + t; stride = 2048; }
                    else { const int rc_ = row - XROWS, b = rc_ >> 8, t = rc_ & 255; vp = Vtc + (size_t)(b * 4) * 64 * 256 + t; stride = 256; }
#pragma unroll
                    for (int bj = 0; bj < 2; ++bj)
#pragma unroll
                        for (int n = 0; n < 2; ++n) {
                            const unsigned w0 = cvt_pk_bf16(acc[ai][bj][m][n][0], acc[ai][bj][m][n][1]), w1 = cvt_pk_bf16(acc[ai][bj][m][n][2], acc[ai][bj][m][n][3]);
                            bf16_t* dp = vp + (size_t)((bj * 2 + (wc >> 1)) * 64 + (wc & 1) * 32 + n * 16 + fq * 4) * stride;
                            dp[0] = (bf16_t)(w0 & 0xffff); dp[stride] = (bf16_t)(w0 >> 16); dp[2 * stride] = (bf16_t)(w1 & 0xffff); dp[3 * stride] = (bf16_t)(w1 >> 16);
                        }
                    asm volatile("" ::: "memory");
                }
        }
    }
};

template <class ColPtr>
__device__ __forceinline__ void conv_t(LAS float* tile, int K, int Nout, int lds, bf16_t* dst, int ldd, ColPtr colptr) {
    const int tilesK = K / 64, nt = tilesK * (Nout / 64);
    const int rr = threadIdx.x & 63, kk = threadIdx.x >> 6, r = threadIdx.x >> 3, kc = (threadIdx.x & 7) * 8;
    for (int t = blockIdx.x; t < nt; t += gridDim.x) {
        const int tk = t % tilesK, tn = t / tilesK;
        const float* sp = colptr(tn * 64 + rr) + (size_t)(tk * 64 + kk * 8) * lds;
        float v[8];
#pragma unroll
        for (int i = 0; i < 8; ++i) v[i] = sp[(size_t)i * lds];
#pragma unroll
        for (int i = 0; i < 8; ++i) tile[rr * 65 + kk * 8 + i] = v[i];
        __syncthreads();
        float o[8];
#pragma unroll
        for (int i = 0; i < 8; ++i) o[i] = tile[r * 65 + kc + i];
        u32x4 w; w.x = cvt_pk_bf16(o[0], o[1]); w.y = cvt_pk_bf16(o[2], o[3]); w.z = cvt_pk_bf16(o[4], o[5]); w.w = cvt_pk_bf16(o[6], o[7]);
        *(u32x4*)(dst + (size_t)(tn * 64 + r) * ldd + tk * 64 + kc) = w;
        __syncthreads();
    }
}

__device__ __forceinline__ void prologue_phase(const Params& p, LAS char* shm) {
    const int tid = threadIdx.x, wid = tid >> 6, lane = tid & 63;
    const int gtid = blockIdx.x * 512 + tid, gsz = gridDim.x * 512;
    if (gtid < 3456) ((unsigned*)(p.ws + OFF_BAR))[gtid] = 0u;
    if (gtid < 1024) {
        const int pos = gtid >> 4, i = gtid & 15;
        const float inv = exp2f(-(float)i * (13.287712379549449f / 16.0f));
        const float ang = (float)pos * inv;
        float* rt = (float*)(p.ws + OFF_ROPE);
        rt[gtid * 2] = __cosf(ang); rt[gtid * 2 + 1] = __sinf(ang);
    }
    if (gtid >= 1024 && gtid < 1024 + 2 * DM) { const int i = gtid - 1024; ((float*)(p.ws + OFF_SPW))[i] = -8.0f * log1pf(__expf(-p.rg_lambda[i])); }
    {
        LAS float* S = (LAS float*)shm;
        float* MOD = (float*)(p.ws + OFF_MOD);
        for (int it = blockIdx.x; it < 2 * 144; it += gridDim.x) {
            const int layer = it / 144, col0 = (it % 144) * 64;
            float acc[NCOND];
#pragma unroll
            for (int cn = 0; cn < NCOND; ++cn) acc[cn] = 0.f;
            for (int half = 0; half < 2; ++half) {
                __syncthreads();
                for (int idx = tid; idx < NCOND * 512; idx += 512) {
                    const int cn = idx >> 9, k = idx & 511;
                    const float v = cn < NB ? p.c[cn * DM + half * 512 + k] : p.c_ctx[half * 512 + k];
                    S[idx] = v / (1.0f + __expf(-v));
                }
                __syncthreads();
                const float* wp = p.w_mod + (size_t)layer * DM * (NMOD * DM) + (size_t)(half * 512 + wid * 64) * (NMOD * DM) + col0 + lane;
#pragma unroll 4
                for (int kb = 0; kb < 64; kb += 4) {
                    const float w0 = wp[(size_t)(kb + 0) * (NMOD * DM)], w1 = wp[(size_t)(kb + 1) * (NMOD * DM)], w2 = wp[(size_t)(kb + 2) * (NMOD * DM)], w3 = wp[(size_t)(kb + 3) * (NMOD * DM)];
#pragma unroll
                    for (int cn = 0; cn < NCOND; ++cn) {
                        const f32x4 s = *(const LAS f32x4*)(S + cn * 512 + wid * 64 + kb);
                        acc[cn] += (w0 * s[0] + w1 * s[1]) + (w2 * s[2] + w3 * s[3]);
                    }
                }
            }
            __syncthreads();
#pragma unroll
            for (int cn = 0; cn < NCOND; ++cn) S[(wid * NCOND + cn) * 64 + lane] = acc[cn];
            __syncthreads();
            for (int idx = tid; idx < NCOND * 64; idx += 512) {
                const int cn = idx >> 6, l = idx & 63;
                float s = p.b_mod[layer * (NMOD * DM) + col0 + l];
#pragma unroll
                for (int w = 0; w < 8; ++w) s += S[(w * NCOND + cn) * 64 + l];
                MOD[(size_t)(layer * NCOND + cn) * (NMOD * DM) + col0 + l] = s;
            }
        }
        __syncthreads();
    }
    LAS float* tile = (LAS float*)shm;
    for (int i = 0; i < 4; ++i) {
        const float* src = p.ffn_w_in + (size_t)i * DM * (2 * DFF);
        conv_t(tile, DM, 2 * DFF, 2 * DFF, (bf16_t*)(p.ws + OFF_W1 + i * SZ_W1), DM, [=](int r) {
            const int pn = r >> 8, q = r & 255;
            return src + (q >> 7) * DFF + pn * 128 + (q & 127); });
    }
    for (int i = 0; i < 4; ++i) {
        const float* src = p.ffn_w_out + (size_t)i * DFF * DM;
        conv_t(tile, DFF, DM, DM, (bf16_t*)(p.ws + OFF_W2 + i * SZ_W2), DFF, [=](int r) { return src + r; });
    }
    { const float* src = p.rg_w_in; conv_t(tile, DM, 2 * DM, 2 * DM, (bf16_t*)(p.ws + OFF_RGIN), DM, [=](int r) { return src + r; }); }
    { const float* src = p.rg_gate_w;
      conv_t(tile, 256, 4096, 256, (bf16_t*)(p.ws + OFF_WG), 256, [=](int r) {
          const int d = r >> 11, n = (r >> 9) & 3, half = (r >> 8) & 1, q = r & 255, g = q >> 7;
          return src + (size_t)(((d * 2 + g) * 4 + n) * 65536) + half * 128 + (q & 127); }); }
    for (int kh = 0; kh < 2; ++kh) { const float* src = p.rg_w_out; conv_t(tile, DM, DM, DM, (bf16_t*)(p.ws + OFF_RGOUT) + kh * DM, 2 * DM, [=](int r) { return src + r; }); }
    { const float* src = p.attn_w_qkv; conv_t(tile, DM, 1536, 1536, (bf16_t*)(p.ws + OFF_QKV), DM, [=](int r) { return src + r; }); }
    { const float* src = p.attn_w_o; conv_t(tile, DM, DM, DM, (bf16_t*)(p.ws + OFF_WO), DM, [=](int r) { return src + r; }); }
}

struct NMArgs {
    const float* hsrc_x; const float* hsrc_c; float* hdst_x; float* hdst_c;
    const bf16_t* Y; const float* ssq; const float* gate_mod; const float* gpost; float coef; int has_pending;
    const float* gpre; const float* shift_mod; const float* scale_mod; int has_next; bf16_t* Aout; int nrows;
};
__device__ __forceinline__ void nm_phase(const NMArgs& a) {
    const int lane = threadIdx.x & 63, wid = threadIdx.x >> 6;
    const int step = gridDim.x * 8;
    for (int row0 = blockIdx.x * 8 + wid; row0 < a.nrows; row0 += 2 * step) {
        int rows[2] = {row0, row0 + step};
        if (rows[1] >= a.nrows) rows[1] = row0;
        f32x4 h[2][4]; u32x2 yw[2][4]; float sq[2] = {0.f, 0.f}; int cn[2];
#pragma unroll
        for (int r = 0; r < 2; ++r) {
            const int row = rows[r]; const bool lat = row < XROWS;
            cn[r] = lat ? (row >> 11) : NB;
            const float* hs = lat ? a.hsrc_x + (size_t)row * DM : a.hsrc_c + (size_t)(row - XROWS) * DM;
#pragma unroll
            for (int ch = 0; ch < 4; ++ch) h[r][ch] = *(const f32x4*)(hs + ch * 256 + lane * 4);
            if (a.has_pending) {
#pragma unroll
                for (int ch = 0; ch < 4; ++ch) yw[r][ch] = *(const u32x2*)(a.Y + (size_t)row * DM + ch * 256 + lane * 4);
                const f32x4 q0 = *(const f32x4*)(a.ssq + (size_t)row * 16), q1 = *(const f32x4*)(a.ssq + (size_t)row * 16 + 4), q2 = *(const f32x4*)(a.ssq + (size_t)row * 16 + 8), q3 = *(const f32x4*)(a.ssq + (size_t)row * 16 + 12);
                const f32x4 qs = (q0 + q1) + (q2 + q3); sq[r] = (qs[0] + qs[1]) + (qs[2] + qs[3]);
            }
        }
#pragma unroll
        for (int r = 0; r < 2; ++r) {
            const int row = rows[r]; const bool lat = row < XROWS;
            if (a.has_pending) {
                const float rstd = rsqrtf(sq[r] * (1.0f / DM) + EPS) * a.coef;
                float* hd = lat ? a.hdst_x + (size_t)row * DM : a.hdst_c + (size_t)(row - XROWS) * DM;
#pragma unroll
                for (int ch = 0; ch < 4; ++ch) {
                    const int e = ch * 256 + lane * 4;
                    const f32x4 y = {bf_lo(yw[r][ch].x), bf_hi(yw[r][ch].x), bf_lo(yw[r][ch].y), bf_hi(yw[r][ch].y)};
                    const f32x4 gm = *(const f32x4*)(a.gate_mod + (size_t)cn[r] * (NMOD * DM) + e), gp = *(const f32x4*)(a.gpost + e);
                    h[r][ch] += gm * ((y * rstd) * gp);
                    *(f32x4*)(hd + e) = h[r][ch];
                }
            }
            if (a.has_next) {
                float ss = 0.f;
#pragma unroll
                for (int ch = 0; ch < 4; ++ch) ss += (h[r][ch][0] * h[r][ch][0] + h[r][ch][1] * h[r][ch][1]) + (h[r][ch][2] * h[r][ch][2] + h[r][ch][3] * h[r][ch][3]);
#pragma unroll
                for (int o = 32; o >= 1; o >>= 1) ss += __shfl_xor(ss, o);
                const float rstd = rsqrtf(ss * (1.0f / DM) + EPS);
#pragma unroll
                for (int ch = 0; ch < 4; ++ch) {
                    const int e = ch * 256 + lane * 4;
                    const f32x4 g = *(const f32x4*)(a.gpre + e), sh = *(const f32x4*)(a.shift_mod + (size_t)cn[r] * (NMOD * DM) + e), sc = *(const f32x4*)(a.scale_mod + (size_t)cn[r] * (NMOD * DM) + e);
                    const f32x4 v = ((h[r][ch] * rstd) * g) * (1.0f + sc) + sh;
                    u32x2 w; w.x = cvt_pk_bf16(v[0], v[1]); w.y = cvt_pk_bf16(v[2], v[3]);
                    *(u32x2*)(a.Aout + (size_t)row * DM + e) = w;
                }
            }
        }
    }
}

__device__ __forceinline__ void conv_phase(const bf16_t* XR, bf16_t* RX, const float* cw, const float* cb) {
    const int total = ROWS * 128;
    for (int i = blockIdx.x * 512 + threadIdx.x; i < total; i += gridDim.x * 512) {
        const int row = i >> 7, c0 = (i & 127) * 8;
        int t, len;
        if (row < XROWS) { t = row & 2047; len = SEQ; } else { t = (row - XROWS) & 255; len = CTX; }
        float acc[8];
        { const f32x4 b0 = *(const f32x4*)(cb + c0), b1 = *(const f32x4*)(cb + c0 + 4);
          acc[0] = b0[0]; acc[1] = b0[1]; acc[2] = b0[2]; acc[3] = b0[3]; acc[4] = b1[0]; acc[5] = b1[1]; acc[6] = b1[2]; acc[7] = b1[3]; }
#pragma unroll
        for (int k = 0; k < 4; ++k) {
            const int tt = t + k - 2;
            if (tt >= 0 && tt < len) {
                const u32x4 xw = *(const u32x4*)(XR + (size_t)(row + k - 2) * DM + c0);
                const f32x4 w0 = *(const f32x4*)(cw + k * DM + c0), w1 = *(const f32x4*)(cw + k * DM + c0 + 4);
                acc[0] += w0[0] * bf_lo(xw.x); acc[1] += w0[1] * bf_hi(xw.x); acc[2] += w0[2] * bf_lo(xw.y); acc[3] += w0[3] * bf_hi(xw.y);
                acc[4] += w1[0] * bf_lo(xw.z); acc[5] += w1[1] * bf_hi(xw.z); acc[6] += w1[2] * bf_lo(xw.w); acc[7] += w1[3] * bf_hi(xw.w);
            }
        }
        u32x4 w; w.x = cvt_pk_bf16(acc[0], acc[1]); w.y = cvt_pk_bf16(acc[2], acc[3]); w.z = cvt_pk_bf16(acc[4], acc[5]); w.w = cvt_pk_bf16(acc[6], acc[7]);
        *(u32x4*)(RX + (size_t)row * DM + c0) = w;
    }
}

__device__ __forceinline__ void scan_phase(const unsigned* AB, const bf16_t* GX, bf16_t* A2, int dir) {
    const int lane = threadIdx.x & 63, wid = threadIdx.x >> 6;
    const int it = wid * gridDim.x + blockIdx.x;
    if (it >= NB * 16) return;
    const int b = it >> 4, c = (it & 15) * 64 + lane;
    constexpr int U = 32, NBATCH = (CTX + SEQ) / U;
    float h = 0.f;
    unsigned ab1[U], ab2[U]; bf16_t gx1[U], gx2[U];
    auto rowof = [&](int bt) -> int {
        const int s = bt * U;
        if (s < CTX) return XROWS + b * CTX + (dir ? (CTX - 1 - s) : s);
        return b * SEQ + (dir ? (SEQ - 1 - (s - CTX)) : (s - CTX));
    };
    const int stp = dir ? -1 : 1;
    { const int r0 = rowof(0), r1 = rowof(1);
#pragma unroll
      for (int i = 0; i < U; ++i) { const size_t o = (size_t)(r0 + stp * i) * DM + c; ab1[i] = AB[o]; gx1[i] = GX[o]; }
#pragma unroll
      for (int i = 0; i < U; ++i) { const size_t o = (size_t)(r1 + stp * i) * DM + c; ab2[i] = AB[o]; gx2[i] = GX[o]; } }
    for (int bt = 0; bt < NBATCH; ++bt) {
        unsigned abc[U]; bf16_t gxc[U];
#pragma unroll
        for (int i = 0; i < U; ++i) { abc[i] = ab1[i]; gxc[i] = gx1[i]; ab1[i] = ab2[i]; gx1[i] = gx2[i]; }
        const int r0 = rowof(bt);
        if (bt + 2 < NBATCH) {
            const int r2 = rowof(bt + 2);
#pragma unroll
            for (int i = 0; i < U; ++i) { const size_t o = (size_t)(r2 + stp * i) * DM + c; ab2[i] = AB[o]; gx2[i] = GX[o]; }
        }
#pragma unroll
        for (int i = 0; i < U; ++i) {
            const float a = __expf(bf_lo(abc[i])), bb = bf_hi(abc[i]);
            h = a * h + bb;
            const float o = __uint_as_float((unsigned)gxc[i] << 16) * h;
            A2[(size_t)(r0 + stp * i) * (2 * DM) + dir * DM + c] = (bf16_t)(cvt_pk_bf16(o, 0.f) & 0xffff);
        }
    }
}

__device__ __forceinline__ void attn_phase(const bf16_t* Q, const bf16_t* Kb, const bf16_t* Vt, const bf16_t* Vtc, const float* sink, bf16_t* O) {
    const int lane = threadIdx.x & 63, wid = threadIdx.x >> 6, fr = lane & 15, fq = lane >> 4;
    for (int it = blockIdx.x * 8 + wid; it < NB * 4 * 128; it += gridDim.x * 8) {
        const int qt = it & 127, kh = (it >> 7) & 3, b = it >> 9, q0 = qt * 16, qpos = q0 + fr;
        bf16x8 qf[4][2];
        { const bf16_t* qp = Q + (size_t)(b * SEQ + q0 + fr) * DM + kh * 256 + fq * 8;
#pragma unroll
          for (int g = 0; g < 4; ++g)
#pragma unroll
              for (int ks = 0; ks < 2; ++ks) qf[g][ks] = *(const bf16x8*)(qp + g * 64 + ks * 32); }
        float mrun[4], lrun[4]; f32x4 o[4][4];
#pragma unroll
        for (int g = 0; g < 4; ++g) { mrun[g] = sink[kh * 4 + g] * 1.4426950408889634f; lrun[g] = 1.0f;
#pragma unroll
            for (int dt = 0; dt < 4; ++dt) o[g][dt] = (f32x4){0.f, 0.f, 0.f, 0.f}; }
        const int ks0 = (q0 & ~31) - 128;
        const int bi_lo = ks0 < 0 ? (-ks0) >> 5 : 0;
        const int bi_hi = (SEQ - ks0 + 31) / 32 < 9 ? (SEQ - ks0 + 31) / 32 : 9;
        const int nlat = bi_hi - bi_lo, nblk = nlat + 8;
        const bf16_t* kbase = Kb + (size_t)(b * SEQ + fr) * 256 + kh * 64 + fq * 8;
        const bf16_t* kcbase = Kb + (size_t)(XROWS + b * CTX + fr) * 256 + kh * 64 + fq * 8;
        const bf16_t* vbase = Vt + ((size_t)(b * 4 + kh) * 64 + fr) * SEQ + fq * 4;
        const bf16_t* vcbase = Vtc + ((size_t)(b * 4 + kh) * 64 + fr) * CTX + fq * 4;
        bf16x8 kfn[2][2]; u32x2 vln[4], vhn[4];
#define ATT_LOAD(i) do { const bool c_ = (i) >= nlat; const int kb_ = c_ ? ((i) - nlat) * 32 : ks0 + (bi_lo + (i)) * 32; \
            const bf16_t* kp_ = (c_ ? kcbase : kbase) + (size_t)kb_ * 256; const bf16_t* vp_ = (c_ ? vcbase : vbase) + kb_; const int vs_ = c_ ? CTX : SEQ; \
            _Pragma("unroll") for (int tl = 0; tl < 2; ++tl) _Pragma("unroll") for (int ks = 0; ks < 2; ++ks) kfn[tl][ks] = *(const bf16x8*)(kp_ + tl * 16 * 256 + ks * 32); \
            _Pragma("unroll") for (int dt = 0; dt < 4; ++dt) { vln[dt] = *(const u32x2*)(vp_ + (size_t)dt * 16 * vs_); vhn[dt] = *(const u32x2*)(vp_ + (size_t)dt * 16 * vs_ + 16); } } while (0)
        ATT_LOAD(0);
        for (int i = 0; i < nblk; ++i) {
            const bool isctx = i >= nlat;
            const int kbs = isctx ? (i - nlat) * 32 : ks0 + (bi_lo + i) * 32;
            const bool need_mask = !isctx && (kbs < q0 - 113 || kbs + 31 > q0 + 128);
            bf16x8 kf[2][2]; bf16x8 vf[4];
#pragma unroll
            for (int tl = 0; tl < 2; ++tl)
#pragma unroll
                for (int ks = 0; ks < 2; ++ks) kf[tl][ks] = kfn[tl][ks];
#pragma unroll
            for (int dt = 0; dt < 4; ++dt) { u32x4 w; w.x = vln[dt].x; w.y = vln[dt].y; w.z = vhn[dt].x; w.w = vhn[dt].y; vf[dt] = __builtin_bit_cast(bf16x8, w); }
            if (i + 1 < nblk) ATT_LOAD(i + 1);
#pragma unroll
            for (int g = 0; g < 4; ++g) {
                f32x4 s0 = {0.f, 0.f, 0.f, 0.f}, s1 = {0.f, 0.f, 0.f, 0.f};
                s0 = __builtin_amdgcn_mfma_f32_16x16x32_bf16(kf[0][0], qf[g][0], s0, 0, 0, 0);
                s0 = __builtin_amdgcn_mfma_f32_16x16x32_bf16(kf[0][1], qf[g][1], s0, 0, 0, 0);
                s1 = __builtin_amdgcn_mfma_f32_16x16x32_bf16(kf[1][0], qf[g][0], s1, 0, 0, 0);
                s1 = __builtin_amdgcn_mfma_f32_16x16x32_bf16(kf[1][1], qf[g][1], s1, 0, 0, 0);
                if (need_mask) {
#pragma unroll
                    for (int j = 0; j < 4; ++j) {
                        const int d0 = kbs + fq * 4 + j - qpos, d1 = d0 + 16;
                        if (d0 > 128 || d0 < -128) s0[j] = -1e30f;
                        if (d1 > 128 || d1 < -128) s1[j] = -1e30f;
                    }
                }
                float mx = fmaxf(fmaxf(fmaxf(s0[0], s0[1]), fmaxf(s0[2], s0[3])), fmaxf(fmaxf(s1[0], s1[1]), fmaxf(s1[2], s1[3])));
                mx = fmaxf(mx, __shfl_xor(mx, 16)); mx = fmaxf(mx, __shfl_xor(mx, 32));
                const float mnew = fmaxf(mrun[g], mx), alpha = __builtin_amdgcn_exp2f(mrun[g] - mnew);
                const bool rescale = __any(mnew != mrun[g]);
                mrun[g] = mnew;
                float p0[4], p1[4], ls = 0.f;
#pragma unroll
                for (int j = 0; j < 4; ++j) { p0[j] = __builtin_amdgcn_exp2f(s0[j] - mnew); p1[j] = __builtin_amdgcn_exp2f(s1[j] - mnew); ls += p0[j] + p1[j]; }
                ls += __shfl_xor(ls, 16); ls += __shfl_xor(ls, 32);
                lrun[g] = lrun[g] * alpha + ls;
                u32x4 pw; pw.x = cvt_pk_bf16(p0[0], p0[1]); pw.y = cvt_pk_bf16(p0[2], p0[3]); pw.z = cvt_pk_bf16(p1[0], p1[1]); pw.w = cvt_pk_bf16(p1[2], p1[3]);
                const bf16x8 pf = __builtin_bit_cast(bf16x8, pw);
                if (rescale) {
#pragma unroll
                    for (int dt = 0; dt < 4; ++dt) o[g][dt] *= alpha;
                }
#pragma unroll
                for (int dt = 0; dt < 4; ++dt) o[g][dt] = __builtin_amdgcn_mfma_f32_16x16x32_bf16(vf[dt], pf, o[g][dt], 0, 0, 0);
            }
        }
#undef ATT_LOAD
#pragma unroll
        for (int g = 0; g < 4; ++g) {
            const float inv = 1.0f / lrun[g];
            bf16_t* op = O + (size_t)(b * SEQ + q0 + fr) * DM + (kh * 4 + g) * 64 + fq * 4;
#pragma unroll
            for (int dt = 0; dt < 4; ++dt) {
                const f32x4 v = o[g][dt] * inv;
                u32x2 w; w.x = cvt_pk_bf16(v[0], v[1]); w.y = cvt_pk_bf16(v[2], v[3]);
                *(u32x2*)(op + dt * 16) = w;
            }
        }
    }
}

#define XB_TMO      128
#define XB_XCNT(j)  (256  + 64 * (j))
#define XB_XSUB(j)  (1280 + 64 * (j))
#define XB_XGEN(j)  (2304 + 64 * (j))
#define XB_TOP      3328
#define XB_TOPGEN   3392
#define XCD_BAR_WORDS 3456
#define XB_SPIN_CAP (1u << 22)
__device__ __forceinline__ unsigned xb_ld(unsigned* p)              { return __hip_atomic_load(p, __ATOMIC_RELAXED, __HIP_MEMORY_SCOPE_AGENT); }
__device__ __forceinline__ unsigned xb_add(unsigned* p, unsigned v) { return __hip_atomic_fetch_add(p, v, __ATOMIC_RELAXED, __HIP_MEMORY_SCOPE_AGENT); }
__device__ __forceinline__ unsigned xb_xcc_id() { return (unsigned)__builtin_amdgcn_s_getreg((3 << 11) | 20) & 0xFu; }
#define XB_SPIN(cond, bar) do { unsigned _sp = 0; while (cond) { __builtin_amdgcn_s_sleep(1); \
    if ((++_sp & 255u) == 0u) { if (xb_ld(&(bar)[XB_TMO])) break; if (_sp > XB_SPIN_CAP) { atomicAdd(&(bar)[XB_TMO], 1u); break; } } } } while (0)
struct XcdBarrier { unsigned* bar; unsigned x; volatile LAS unsigned* st; };
__device__ __forceinline__ XcdBarrier xcd_barrier_post(unsigned* bar, volatile LAS unsigned* st) {
    XcdBarrier b; b.bar = bar; b.x = xb_xcc_id(); b.st = st;
    if (threadIdx.x == 0) (void)xb_add(&bar[XB_XCNT(b.x)], 1u);
    return b;
}
__device__ __forceinline__ void xcd_barrier_complete(unsigned* bar, unsigned x, unsigned& nloc, unsigned& nx) {
    const unsigned G = gridDim.x * gridDim.y * gridDim.z;
    unsigned sum, cnt, mine, sp = 0u;
    for (;;) {
        sum = 0u; cnt = 0u; mine = 0u;
#pragma unroll
        for (unsigned j = 0; j < 16; ++j) { const unsigned c = xb_ld(&bar[XB_XCNT(j)]); sum += c; cnt += (c > 0u) ? 1u : 0u; mine = (j == x) ? c : mine; }
        if (sum == G) break;
        __builtin_amdgcn_s_sleep(1);
        if ((++sp & 255u) == 0u) { if (xb_ld(&bar[XB_TMO])) break; if (sp > XB_SPIN_CAP) { atomicAdd(&bar[XB_TMO], 1u); break; } }
    }
    nloc = mine > 0u ? mine : 1u; nx = cnt > 0u ? cnt : 1u;
}
__device__ __forceinline__ void xcd_barrier(const XcdBarrier& b) {
    asm volatile("s_waitcnt vmcnt(0)" ::: "memory");
    __syncthreads();
    if (threadIdx.x == 0) {
        unsigned* bar = b.bar;
        __builtin_amdgcn_s_waitcnt(0);
        unsigned nloc = b.st[0], nx = b.st[1];
        if (nloc == 0u) { xcd_barrier_complete(bar, b.x, nloc, nx); b.st[0] = nloc; b.st[1] = nx; }
        const unsigned old = xb_add(&bar[XB_XSUB(b.x)], 1u);
        const unsigned gen = old / nloc;
        if (old + 1u == (gen + 1u) * nloc) {
            __builtin_amdgcn_fence(__ATOMIC_RELEASE, "agent");
            asm volatile("s_waitcnt vmcnt(0)" ::: "memory");
            const unsigned og = xb_add(&bar[XB_TOP], 1u);
            const unsigned tg = og / nx;
            if (og + 1u == (tg + 1u) * nx) xb_add(&bar[XB_TOPGEN], 1u);
            else XB_SPIN(xb_ld(&bar[XB_TOPGEN]) == tg, bar);
            __builtin_amdgcn_fence(__ATOMIC_ACQUIRE, "agent");
            xb_add(&bar[XB_XGEN(b.x)], 1u);
            asm volatile("s_waitcnt vmcnt(0)" ::: "memory");
        } else {
            XB_SPIN(xb_ld(&bar[XB_XGEN(b.x)]) == gen, bar);
            __builtin_amdgcn_fence(__ATOMIC_ACQUIRE, "agent");
            asm volatile("s_waitcnt vmcnt(0)" ::: "memory");
        }
    }
    __syncthreads();
}

constexpr int N_PHASES = 26;
enum { T_PRE, T_NM, T_W1, T_Y, T_RGIN, T_CONV, T_GATE, T_SCAN, T_QKV, T_ATTN };
struct PhaseDesc {
    int type = T_PRE;
    int nm_first = 0, nm_pl = 0, nm_pidx = 0, nm_pg = 0, nm_ssq = 0, nm_py3 = 0, nm_nl = 0, nm_nidx = 0, nm_ng = 0, nm_next = 1, nm_rows = ROWS; float nm_coef = 0.5f;
    int w_idx = 0, nM = ROWS / 256, ssq_i = 0, dir = 0, ykind = 0;
};
constexpr PhaseDesc phase_desc(int ph) {
    PhaseDesc d;
    switch (ph) {
        case 0: d.type = T_PRE; break;
        case 1: d.type = T_NM; d.nm_first = 1; d.nm_nl = 0; d.nm_nidx = 0; d.nm_ng = 0; break;
        case 2: d.type = T_W1; d.w_idx = 0; break;
        case 3: d.type = T_Y; d.ykind = 0; d.w_idx = 0; d.ssq_i = 0; break;
        case 4: d.type = T_NM; d.nm_pl = 0; d.nm_pidx = 2; d.nm_pg = 3; d.nm_ssq = 0; d.nm_nl = 0; d.nm_nidx = 3; d.nm_ng = 1; break;
        case 5: d.type = T_RGIN; break;
        case 6: d.type = T_CONV; break;
        case 7: d.type = T_GATE; d.dir = 0; break;
        case 8: d.type = T_SCAN; d.dir = 0; break;
        case 9: d.type = T_GATE; d.dir = 1; break;
        case 10: d.type = T_SCAN; d.dir = 1; break;
        case 11: d.type = T_Y; d.ykind = 1; d.ssq_i = 1; break;
        case 12: d.type = T_NM; d.nm_pl = 0; d.nm_pidx = 5; d.nm_pg = 4; d.nm_ssq = 1; d.nm_py3 = 1; d.nm_coef = 1.0f; d.nm_nl = 0; d.nm_nidx = 6; d.nm_ng = 2; break;
        case 13: d.type = T_W1; d.w_idx = 1; break;
        case 14: d.type = T_Y; d.ykind = 0; d.w_idx = 1; d.ssq_i = 2; break;
        case 15: d.type = T_NM; d.nm_pl = 0; d.nm_pidx = 8; d.nm_pg = 5; d.nm_ssq = 2; d.nm_nl = 1; d.nm_nidx = 0; d.nm_ng = 0; break;
        case 16: d.type = T_W1; d.w_idx = 2; break;
        case 17: d.type = T_Y; d.ykind = 0; d.w_idx = 2; d.ssq_i = 3; break;
        case 18: d.type = T_NM; d.nm_pl = 1; d.nm_pidx = 2; d.nm_pg = 3; d.nm_ssq = 3; d.nm_nl = 1; d.nm_nidx = 3; d.nm_ng = 1; break;
        case 19: d.type = T_QKV; break;
        case 20: d.type = T_ATTN; break;
        case 21: d.type = T_Y; d.ykind = 2; d.ssq_i = 4; d.nM = XROWS / 256; break;
        case 22: d.type = T_NM; d.nm_pl = 1; d.nm_pidx = 5; d.nm_pg = 4; d.nm_ssq = 4; d.nm_py3 = 1; d.nm_coef = 1.0f; d.nm_nl = 1; d.nm_nidx = 6; d.nm_ng = 2; d.nm_rows = XROWS; break;
        case 23: d.type = T_W1; d.w_idx = 3; d.nM = XROWS / 256; break;
        case 24: d.type = T_Y; d.ykind = 0; d.w_idx = 3; d.ssq_i = 5; d.nM = XROWS / 256; break;
        default: d.type = T_NM; d.nm_pl = 1; d.nm_pidx = 8; d.nm_pg = 5; d.nm_ssq = 5; d.nm_next = 0; d.nm_rows = XROWS; break;
    }
    return d;
}

#ifndef TMASK
#define TMASK 0x3ff
#endif
template <int PH>
__device__ __forceinline__ void run_phase(const Params& p, LAS char* shm) {
    constexpr PhaseDesc d = phase_desc(PH);
    if constexpr (((TMASK >> d.type) & 1) != 0) {
    char* ws = p.ws;
    bf16_t* R0 = (bf16_t*)(ws + OFF_R0); bf16_t* R1 = (bf16_t*)(ws + OFF_R1); bf16_t* R2 = (bf16_t*)(ws + OFF_R2); bf16_t* R3 = (bf16_t*)(ws + OFF_R3); bf16_t* R4 = (bf16_t*)(ws + OFF_R4);
    float* MOD = (float*)(ws + OFF_MOD); float* SSQ = (float*)(ws + OFF_SSQ); float* HC = (float*)(ws + OFF_HC);
    if constexpr (d.type == T_PRE) prologue_phase(p, shm);
    else if constexpr (d.type == T_NM) {
        NMArgs a;
        a.hsrc_x = (PH <= 4) ? p.x : p.out; a.hsrc_c = (PH <= 4) ? p.ctx : HC; a.hdst_x = p.out; a.hdst_c = HC;
        a.Y = d.nm_py3 ? R3 : R1; a.ssq = SSQ;
        a.gate_mod = MOD + (size_t)d.nm_pl * NCOND * (NMOD * DM) + d.nm_pidx * DM; a.gpost = p.norm_g + (d.nm_pl * 6 + d.nm_pg) * DM; a.coef = d.nm_coef; a.has_pending = !d.nm_first;
        a.gpre = p.norm_g + (d.nm_nl * 6 + d.nm_ng) * DM; a.shift_mod = MOD + (size_t)d.nm_nl * NCOND * (NMOD * DM) + d.nm_nidx * DM; a.scale_mod = a.shift_mod + DM;
        a.has_next = d.nm_next; a.Aout = R0; a.nrows = d.nm_rows;
        nm_phase(a);
    } else if constexpr (d.type == T_W1) { EpiSwiglu e{R2}; gemm_phase<false>(shm, R0, DM, (const bf16_t*)(ws + OFF_W1 + d.w_idx * SZ_W1), DM, d.nM, 22, DM, e); }
    else if constexpr (d.type == T_Y) {
        if constexpr (d.ykind == 0) { EpiY e{R1, SSQ}; gemm_phase<false>(shm, R2, DFF, (const bf16_t*)(ws + OFF_W2 + d.w_idx * SZ_W2), DFF, d.nM, 4, DFF, e); }
        else if constexpr (d.ykind == 1) { EpiY e{R3, SSQ}; gemm_phase<false>(shm, R0, 2 * DM, (const bf16_t*)(ws + OFF_RGOUT), 2 * DM, d.nM, 4, 2 * DM, e); }
        else { EpiY e{R3, SSQ}; gemm_phase<false>(shm, R1, DM, (const bf16_t*)(ws + OFF_WO), DM, d.nM, 4, DM, e); }
    } else if constexpr (d.type == T_RGIN) { EpiRgIn e{R2, R1}; gemm_phase<false>(shm, R0, DM, (const bf16_t*)(ws + OFF_RGIN), DM, ROWS / 256, 8, DM, e); }
    else if constexpr (d.type == T_CONV) conv_phase(R1, R3, p.rg_conv_w, p.rg_conv_b);
    else if constexpr (d.type == T_GATE) {
        EpiGate e{R3, (unsigned*)R4, p.rg_gate_b + (d.dir * 2 + 0) * DM, p.rg_gate_b + (d.dir * 2 + 1) * DM, (const float*)(ws + OFF_SPW) + d.dir * DM};
        gemm_phase<true>(shm, R3, DM, (const bf16_t*)(ws + OFF_WG) + (size_t)d.dir * 8 * 65536, 256, ROWS / 256, 8, 256, e);
    } else if constexpr (d.type == T_SCAN) scan_phase((const unsigned*)R4, R2, R0, d.dir);
    else if constexpr (d.type == T_QKV) {
        EpiQkv e{R2, R4, (bf16_t*)(ws + OFF_R4 + 40 * MiB), (bf16_t*)(ws + OFF_R4 + 80 * MiB), (const float*)(ws + OFF_ROPE)};
        gemm_phase<false>(shm, R0, DM, (const bf16_t*)(ws + OFF_QKV), DM, ROWS / 256, 6, DM, e);
    } else if constexpr (d.type == T_ATTN) attn_phase(R2, R4, (const bf16_t*)(ws + OFF_R4 + 40 * MiB), (const bf16_t*)(ws + OFF_R4 + 80 * MiB), p.attn_sink, R1);
    }
}

template <int PH>
__device__ __forceinline__ void do_phase(const Params& p, LAS char* shm, cg::grid_group& grid, XcdBarrier& xb) {
    if (PH >= (int)p.ph_lo && PH < (int)p.ph_hi) {
        if (PH > (int)p.ph_lo) {
            if constexpr (PH == 1) {
                grid.sync();
                volatile LAS unsigned* st = (volatile LAS unsigned*)(shm + STAGE_BYTES);
                if (threadIdx.x < 2) st[threadIdx.x] = 0u;
                __syncthreads();
                xb = xcd_barrier_post((unsigned*)(p.ws + OFF_BAR), st);
            } else xcd_barrier(xb);
        }
        run_phase<PH>(p, shm);
#ifdef REPEAT_MASK
        if constexpr (((REPEAT_MASK >> phase_desc(PH).type) & 1) != 0 && PH > 0) { xcd_barrier(xb); run_phase<PH>(p, shm); }
#endif
#ifdef REPEAT_PH
        if constexpr (((REPEAT_PH >> PH) & 1) != 0 && PH > 0) { xcd_barrier(xb); run_phase<PH>(p, shm); }
#endif
#ifdef EXTRA_SYNCS
        if constexpr (PH == 1) { for (int i = 0; i < EXTRA_SYNCS; ++i) xcd_barrier(xb); }
#endif
    }
}

__global__ void __launch_bounds__(512) fwd_megakernel(Params p) {
    __shared__ __attribute__((aligned(1024))) char shm_[STAGE_BYTES + 256];
    LAS char* shm = (LAS char*)shm_;
    cg::grid_group grid = cg::this_grid();
    XcdBarrier xb; xb.bar = (unsigned*)(p.ws + OFF_BAR); xb.x = 0; xb.st = (volatile LAS unsigned*)(shm + STAGE_BYTES);
    do_phase<0>(p, shm, grid, xb); do_phase<1>(p, shm, grid, xb); do_phase<2>(p, shm, grid, xb); do_phase<3>(p, shm, grid, xb); do_phase<4>(p, shm, grid, xb);
    do_phase<5>(p, shm, grid, xb); do_phase<6>(p, shm, grid, xb); do_phase<7>(p, shm, grid, xb); do_phase<8>(p, shm, grid, xb); do_phase<9>(p, shm, grid, xb);
    do_phase<10>(p, shm, grid, xb); do_phase<11>(p, shm, grid, xb); do_phase<12>(p, shm, grid, xb); do_phase<13>(p, shm, grid, xb); do_phase<14>(p, shm, grid, xb);
    do_phase<15>(p, shm, grid, xb); do_phase<16>(p, shm, grid, xb); do_phase<17>(p, shm, grid, xb); do_phase<18>(p, shm, grid, xb); do_phase<19>(p, shm, grid, xb);
    do_phase<20>(p, shm, grid, xb); do_phase<21>(p, shm, grid, xb); do_phase<22>(p, shm, grid, xb); do_phase<23>(p, shm, grid, xb); do_phase<24>(p, shm, grid, xb);
    do_phase<25>(p, shm, grid, xb);
}

extern "C" void kernel_launch(void* const* d_in, const int* in_sizes, int n_in, void* d_out, int out_size, void* d_ws, size_t ws_size, hipStream_t stream) {
    static int grid_blocks = 0;
    if (!grid_blocks) {
        int dev = 0, cus = 0, per_cu = 0;
        hipGetDevice(&dev);
        hipDeviceGetAttribute(&cus, hipDeviceAttributeMultiprocessorCount, dev);
        hipOccupancyMaxActiveBlocksPerMultiprocessor(&per_cu, fwd_megakernel, 512, 0);
        if (per_cu < 1) per_cu = 1;
        if (per_cu > 1) per_cu = 1;
        grid_blocks = cus * per_cu;
        if (grid_blocks % 8) grid_blocks -= grid_blocks % 8;
        if (ws_size < WS_END || n_in != 19) { fprintf(stderr, "kernel_launch: unexpected workspace %zu (< %zu) or n_in %d\n", ws_size, (size_t)WS_END, n_in); }
    }
    Params p{};
    const float** pp = (const float**)&p;
    for (int i = 0; i < 19; ++i) pp[i] = (const float*)d_in[i];
    p.out = (float*)d_out; p.ws = (char*)d_ws;
#if MK_MULTI
    for (int ph = 0; ph < N_PHASES; ++ph) {
        p.ph_lo = ph; p.ph_hi = ph + 1;
        hipLaunchKernelGGL(fwd_megakernel, dim3(grid_blocks), dim3(512), 0, stream, p);
    }
#else
    p.ph_lo = 0; p.ph_hi = N_PHASES;
    void* args[] = {&p};
    hipError_t e = hipLaunchCooperativeKernel((void*)fwd_megakernel, dim3(grid_blocks), dim3(512), args, 0, stream);
    if (e != hipSuccess) fprintf(stderr, "cooperative launch failed: %s (grid %d)\n", hipGetErrorString(e), grid_blocks);
#endif
}
```
